# Optimizing an MI355X kernel written in HIP

```python
import math
import jax, jax.numpy as jnp
from jax import lax
import numpy as np

D_MODEL = 2048
BATCH = 8
SEQ = 2048
DEPTH = 1
DEC_BATCH = 128
DEC_SEQ = 1
PAST_LEN = 16384
PAGE_SIZE = 128

N_META = 16
D_SSM = D_MODEL // 2
SSM_GROUP = 16
N_SSM_GROUPS = D_SSM // SSM_GROUP
SSM_STATE = 64
HEAD_DIM = 64
N_HEADS = (D_MODEL - D_SSM) // HEAD_DIM
N_KV_HEADS = 4
Q_PER_KV = N_HEADS // N_KV_HEADS
D_ATTN = N_HEADS * HEAD_DIM
D_KV = N_KV_HEADS * HEAD_DIM
D_IN = D_SSM + D_ATTN + 2 * D_KV
WINDOW = 128
BLOCK = 128
ROPE_THETA = 10000.0
D_FF = 5632
CONV_W = 3
EPS = 1e-6
NEG = -1e30

kernel_name = "hymba_s5_swa_convffn_step"


def rmsnorm(x, g):
    xf = x.astype(jnp.float32)
    y = xf * lax.rsqrt(jnp.mean(xf * xf, axis=-1, keepdims=True) + EPS) * g.astype(jnp.float32)
    return y.astype(x.dtype)


def rope(x, pos):
    half = HEAD_DIM // 2
    inv = ROPE_THETA ** (-jnp.arange(half, dtype=jnp.float32) * 2.0 / HEAD_DIM)
    ang = pos.astype(jnp.float32)[:, None] * inv[None, :]
    cos = jnp.cos(ang)[:, None, :]
    sin = jnp.sin(ang)[:, None, :]
    xf = x.astype(jnp.float32)
    x1, x2 = xf[..., :half], xf[..., half:]
    return jnp.concatenate([x1 * cos - x2 * sin, x1 * sin + x2 * cos], axis=-1).astype(x.dtype)


def project(h, w_in, q_norm_g, k_norm_g, pos):
    bn, t, _ = h.shape
    z = h @ w_in
    u = z[..., :D_SSM]
    q = z[..., D_SSM:D_SSM + D_ATTN].reshape(bn, t, N_HEADS, HEAD_DIM)
    k = z[..., D_SSM + D_ATTN:D_SSM + D_ATTN + D_KV].reshape(bn, t, N_KV_HEADS, HEAD_DIM)
    v = z[..., D_SSM + D_ATTN + D_KV:].reshape(bn, t, N_KV_HEADS, HEAD_DIM)
    q = rope(rmsnorm(q, q_norm_g), pos)
    k = rope(rmsnorm(k, k_norm_g), pos)
    return u, q, k, v


def _cscan_combine(e1, e2):
    a1r, a1i, b1r, b1i = e1
    a2r, a2i, b2r, b2i = e2
    return (a2r * a1r - a2i * a1i,
            a2r * a1i + a2i * a1r,
            a2r * b1r - a2i * b1i + b2r,
            a2r * b1i + a2i * b1r + b2i)


def s5_mixer(u, h0_re, h0_im, lam_re, lam_im, log_dt, b_re, b_im, c_re, c_im, d_skip, w_glu, b_glu):
    bn, t, _ = u.shape
    uf = u.astype(jnp.float32).reshape(bn, t, N_SSM_GROUPS, SSM_GROUP)
    dt = jnp.exp(log_dt.astype(jnp.float32))[:, None]
    lr = lam_re.astype(jnp.float32)
    li = lam_im.astype(jnp.float32)
    mag = jnp.exp(lr * dt)
    a_re = mag * jnp.cos(li * dt)
    a_im = mag * jnp.sin(li * dt)
    den = lr * lr + li * li
    am1 = a_re - 1.0
    coef_re = (am1 * lr + a_im * li) / den
    coef_im = (a_im * lr - am1 * li) / den
    bu_re = jnp.einsum('btgh,gph->btgp', uf, b_re.astype(jnp.float32))
    bu_im = jnp.einsum('btgh,gph->btgp', uf, b_im.astype(jnp.float32))
    x_re = coef_re * bu_re - coef_im * bu_im
    x_im = coef_re * bu_im + coef_im * bu_re
    h0r = h0_re.astype(jnp.float32)
    h0i = h0_im.astype(jnp.float32)
    x_re = x_re.at[:, 0].add(a_re * h0r - a_im * h0i)
    x_im = x_im.at[:, 0].add(a_re * h0i + a_im * h0r)
    a_re_b = jnp.broadcast_to(a_re, x_re.shape)
    a_im_b = jnp.broadcast_to(a_im, x_im.shape)
    _, _, s_re, s_im = lax.associative_scan(_cscan_combine, (a_re_b, a_im_b, x_re, x_im), axis=1)
    y = (jnp.einsum('btgp,ghp->btgh', s_re, c_re.astype(jnp.float32))
         - jnp.einsum('btgp,ghp->btgh', s_im, c_im.astype(jnp.float32)))
    y = y + d_skip.astype(jnp.float32) * uf
    y = jax.nn.gelu(y.reshape(bn, t, D_SSM)).astype(u.dtype)
    y = y * jax.nn.sigmoid(y @ w_glu + b_glu)
    return y, s_re[:, -1], s_im[:, -1]


def _sink_softmax(s, sinks_b):
    sink_col = jnp.broadcast_to(sinks_b, s.shape[:-1] + (1,))
    p = jax.nn.softmax(jnp.concatenate([s, sink_col], axis=-1), axis=-1)
    return p[..., :-1]


def swa_prompt(q, k, v, sinks):
    bn, t = q.shape[:2]
    pad = (-t) % BLOCK
    tp = t + pad
    nb = tp // BLOCK
    padw = ((0, 0), (pad, 0), (0, 0), (0, 0))
    qb = jnp.pad(q, padw).reshape(bn, nb, BLOCK, N_KV_HEADS, Q_PER_KV, HEAD_DIM)
    kb = jnp.pad(k, padw).reshape(bn, nb, BLOCK, N_KV_HEADS, HEAD_DIM)
    vb = jnp.pad(v, padw).reshape(bn, nb, BLOCK, N_KV_HEADS, HEAD_DIM)
    shift = ((0, 0), (1, 0), (0, 0), (0, 0), (0, 0))
    k2 = jnp.concatenate([jnp.pad(kb, shift)[:, :-1], kb], axis=2)
    v2 = jnp.concatenate([jnp.pad(vb, shift)[:, :-1], vb], axis=2)
    s = jnp.einsum('bnqkgd,bnskd->bnkgqs', qb, k2).astype(jnp.float32) * (HEAD_DIM ** -0.5)
    blk = jnp.arange(nb)[:, None] * BLOCK
    qi = blk + jnp.arange(BLOCK)[None, :]
    ki = blk - BLOCK + jnp.arange(2 * BLOCK)[None, :]
    diff = qi[:, :, None] - ki[:, None, :]
    mask = (diff >= 0) & (diff < WINDOW) & (ki[:, None, :] >= pad)
    s = jnp.where(mask[None, :, None, None], s, NEG)
    sk = sinks.astype(jnp.float32).reshape(N_KV_HEADS, Q_PER_KV)[None, None, :, :, None, None]
    p = _sink_softmax(s, sk)
    o = jnp.einsum('bnkgqs,bnskd->bnqkgd', p.astype(v.dtype), v2)
    return o.reshape(bn, tp, D_ATTN)[:, pad:]


def swa_sample(q, k, v, ck, cv, sinks):
    bn, s_len = q.shape[:2]
    k_all = jnp.concatenate([ck.astype(k.dtype), k], axis=1)
    v_all = jnp.concatenate([cv.astype(v.dtype), v], axis=1)
    qg = q.reshape(bn, s_len, N_KV_HEADS, Q_PER_KV, HEAD_DIM)
    s = jnp.einsum('bqkgd,bskd->bkgqs', qg, k_all).astype(jnp.float32) * (HEAD_DIM ** -0.5)
    qpos = PAST_LEN + jnp.arange(s_len)
    kpos = PAST_LEN - WINDOW + jnp.arange(WINDOW + s_len)
    diff = qpos[:, None] - kpos[None, :]
    mask = (diff >= 0) & (diff < WINDOW)
    s = jnp.where(mask, s, NEG)
    sk = sinks.astype(jnp.float32).reshape(N_KV_HEADS, Q_PER_KV)[None, :, :, None, None]
    p = _sink_softmax(s, sk)
    o = jnp.einsum('bkgqs,bskd->bqkgd', p.astype(v.dtype), v_all).reshape(bn, s_len, D_ATTN)
    return o, k_all[:, -WINDOW:], v_all[:, -WINDOW:]


def conv_ffn(h, buf, w_up, conv_w, conv_b, w_down):
    t = h.shape[1]
    up = h @ w_up
    xp = jnp.concatenate([buf.astype(up.dtype), up], axis=1)
    c = conv_b
    for j in range(CONV_W):
        c = c + conv_w[j] * xp[:, j:j + t]
    val, gate = c[..., :D_FF], c[..., D_FF:]
    out = (jax.nn.silu(gate) * val) @ w_down
    return out, xp[:, -(CONV_W - 1):]


def block(x, pos, attn_cache, h0_re, h0_im, conv_buf, norm_mix_g, w_in, q_norm_g, k_norm_g, attn_sinks,
          lam_re, lam_im, log_dt, ssm_b_re, ssm_b_im, ssm_c_re, ssm_c_im, ssm_d, w_glu, b_glu,
          ssm_out_g, attn_out_g, w_out, norm_ffn_g, w_up, conv_w, conv_b, w_down):
    h = rmsnorm(x, norm_mix_g)
    u, q, k, v = project(h, w_in, q_norm_g, k_norm_g, pos)
    y_ssm, s_re, s_im = s5_mixer(u, h0_re, h0_im, lam_re, lam_im, log_dt, ssm_b_re, ssm_b_im,
                                 ssm_c_re, ssm_c_im, ssm_d, w_glu, b_glu)
    if attn_cache is None:
        y_att = swa_prompt(q, k, v, attn_sinks)
        nk, nv = k[:, -WINDOW:], v[:, -WINDOW:]
    else:
        y_att, nk, nv = swa_sample(q, k, v, attn_cache[0], attn_cache[1], attn_sinks)
    mixed = jnp.concatenate([rmsnorm(y_ssm, ssm_out_g), rmsnorm(y_att.astype(x.dtype), attn_out_g)], axis=-1)
    x = x + mixed @ w_out
    f, new_buf = conv_ffn(rmsnorm(x, norm_ffn_g), conv_buf, w_up, conv_w, conv_b, w_down)
    x = x + f
    return x, nk, nv, s_re, s_im, new_buf


def setup_inputs(seed: int = 0) -> dict:
    key = jax.random.key(seed)
    ks = iter(jax.random.split(key, 40))
    f32 = jnp.float32

    def nrm(shape, scale):
        return jax.random.normal(next(ks), shape, f32) * scale

    G, P, H = N_SSM_GROUPS, SSM_STATE, SSM_GROUP
    d = {}
    d['x_prompt'] = nrm((BATCH, SEQ, D_MODEL), 1.0)
    d['x_sample'] = nrm((DEC_BATCH, DEC_SEQ, D_MODEL), 1.0)
    d['cache_k'] = nrm((DEPTH, DEC_BATCH, WINDOW, N_KV_HEADS, HEAD_DIM), 1.0)
    d['cache_v'] = nrm((DEPTH, DEC_BATCH, WINDOW, N_KV_HEADS, HEAD_DIM), 1.0)
    d['state_ssm_re'] = nrm((DEPTH, DEC_BATCH, G, P), 0.1)
    d['state_ssm_im'] = nrm((DEPTH, DEC_BATCH, G, P), 0.1)
    d['state_conv'] = nrm((DEPTH, DEC_BATCH, CONV_W - 1, 2 * D_FF), 1.0)
    d['meta_tokens'] = nrm((N_META, D_MODEL), 1.0)
    d['norm_mix_g'] = 1.0 + nrm((DEPTH, D_MODEL), 0.02)
    d['w_in'] = nrm((DEPTH, D_MODEL, D_IN), D_MODEL ** -0.5)
    d['q_norm_g'] = 1.0 + nrm((DEPTH, HEAD_DIM), 0.02)
    d['k_norm_g'] = 1.0 + nrm((DEPTH, HEAD_DIM), 0.02)
    d['attn_sinks'] = nrm((DEPTH, N_HEADS), 0.5)
    d['lam_re'] = -0.5 + nrm((DEPTH, G, P), 0.01)
    d['lam_im'] = math.pi * jnp.arange(P, dtype=f32)[None, None, :] + nrm((DEPTH, G, P), 0.01)
    d['log_dt'] = jax.random.uniform(next(ks), (DEPTH, G), f32, math.log(1e-3), math.log(1e-1))
    d['ssm_b_re'] = nrm((DEPTH, G, P, H), (2 * H) ** -0.5)
    d['ssm_b_im'] = nrm((DEPTH, G, P, H), (2 * H) ** -0.5)
    d['ssm_c_re'] = nrm((DEPTH, G, H, P), (2 * P) ** -0.5)
    d['ssm_c_im'] = nrm((DEPTH, G, H, P), (2 * P) ** -0.5)
    d['ssm_d'] = nrm((DEPTH, G, H), 1.0)
    d['w_glu'] = nrm((DEPTH, D_SSM, D_SSM), D_SSM ** -0.5)
    d['b_glu'] = nrm((DEPTH, D_SSM), 0.01)
    d['ssm_out_g'] = 1.0 + nrm((DEPTH, D_SSM), 0.02)
    d['attn_out_g'] = 1.0 + nrm((DEPTH, D_ATTN), 0.02)
    d['w_out'] = nrm((DEPTH, D_SSM + D_ATTN, D_MODEL), (D_SSM + D_ATTN) ** -0.5)
    d['norm_ffn_g'] = 1.0 + nrm((DEPTH, D_MODEL), 0.02)
    d['w_up'] = nrm((DEPTH, D_MODEL, 2 * D_FF), D_MODEL ** -0.5)
    d['conv_w'] = nrm((DEPTH, CONV_W, 2 * D_FF), CONV_W ** -0.5)
    d['conv_b'] = nrm((DEPTH, 2 * D_FF), 0.01)
    d['w_down'] = nrm((DEPTH, D_FF, D_MODEL), D_FF ** -0.5)
    return d


def reference(x_prompt, x_sample, cache_k, cache_v, state_ssm_re, state_ssm_im, state_conv,
              meta_tokens, norm_mix_g, w_in, q_norm_g, k_norm_g, attn_sinks, lam_re, lam_im, log_dt,
              ssm_b_re, ssm_b_im, ssm_c_re, ssm_c_im, ssm_d, w_glu, b_glu, ssm_out_g, attn_out_g,
              w_out, norm_ffn_g, w_up, conv_w, conv_b, w_down):
    xp = jnp.concatenate([jnp.broadcast_to(meta_tokens.astype(x_prompt.dtype)[None], (BATCH, N_META, D_MODEL)),
                          x_prompt], axis=1)
    pos_p = jnp.arange(N_META + SEQ)
    xs = x_sample
    pos_s = PAST_LEN + jnp.arange(DEC_SEQ)
    zero_re = jnp.zeros((BATCH, N_SSM_GROUPS, SSM_STATE), jnp.float32)
    zero_buf = jnp.zeros((BATCH, CONV_W - 1, 2 * D_FF), x_prompt.dtype)

    pk, pv, pre, pim, pconv = [], [], [], [], []
    sk, sv, sre, sim, sconv = [], [], [], [], []
    for l in range(DEPTH):
        w_l = (norm_mix_g[l], w_in[l], q_norm_g[l], k_norm_g[l], attn_sinks[l], lam_re[l], lam_im[l], log_dt[l],
               ssm_b_re[l], ssm_b_im[l], ssm_c_re[l], ssm_c_im[l], ssm_d[l], w_glu[l], b_glu[l],
               ssm_out_g[l], attn_out_g[l], w_out[l], norm_ffn_g[l], w_up[l], conv_w[l], conv_b[l], w_down[l])
        xp, k1, v1, r1, i1, c1 = block(xp, pos_p, None, zero_re, zero_re, zero_buf, *w_l)
        pk.append(k1); pv.append(v1); pre.append(r1); pim.append(i1); pconv.append(c1)
        xs, k2, v2, r2, i2, c2 = block(xs, pos_s, (cache_k[l], cache_v[l]), state_ssm_re[l], state_ssm_im[l],
                                       state_conv[l], *w_l)
        sk.append(k2); sv.append(v2); sre.append(r2); sim.append(i2); sconv.append(c2)

    y_prompt = xp[:, N_META:]
    y_sample = xs
    return (y_prompt, y_sample,
            jnp.stack(pk), jnp.stack(pv), jnp.stack(pre), jnp.stack(pim), jnp.stack(pconv),
            jnp.stack(sk), jnp.stack(sv), jnp.stack(sre), jnp.stack(sim), jnp.stack(sconv))
```

```cpp
#include <hip/hip_runtime.h>
#include <hip/hip_cooperative_groups.h>
#include <cstdio>
#include <cstdint>
namespace cg = cooperative_groups;

#define LAS __attribute__((address_space(3)))
typedef unsigned short bf16_t;
typedef short bf16x8 __attribute__((ext_vector_type(8)));
typedef float f32x4 __attribute__((ext_vector_type(4)));
typedef float f32x2 __attribute__((ext_vector_type(2)));
typedef float f32x16 __attribute__((ext_vector_type(16)));
typedef unsigned u32x4 __attribute__((ext_vector_type(4)));
typedef unsigned u32x2 __attribute__((ext_vector_type(2)));

constexpr int DM = 2048, NB = 8, SEQ = 2048, NMETA = 16, TP = SEQ + NMETA, NPR = NB * TP, NS = 128, MROWS = NPR + NS;
constexpr int DSSM = 1024, DATT = 1024, DKV = 256, DIN = 2560, DFF = 5632, DFF2 = 11264, ZP = DIN;
constexpr int PASTLEN = 16384, NROPE = TP + 1;
constexpr float EPS = 1e-6f;
static_assert(MROWS % 256 == 0, "rows");

constexpr size_t WS_WIN = 0;
constexpr size_t WS_WGLU = WS_WIN + (size_t)DIN * DM * 2;
constexpr size_t WS_WOUT = WS_WGLU + (size_t)DSSM * DSSM * 2;
constexpr size_t WS_WUP = WS_WOUT + (size_t)DM * DM * 2;
constexpr size_t WS_WDOWN = WS_WUP + (size_t)DFF2 * DM * 2;
constexpr size_t WS_ROPE = WS_WDOWN + (size_t)DM * DFF * 2;
constexpr size_t WS_CTL = WS_ROPE + 786432, CTL_BYTES = 32768;
constexpr size_t WS_SSQS = WS_ROPE + (1u << 20);
constexpr size_t WS_SSQA = WS_SSQS + (size_t)MROWS * 16 * 4;
constexpr size_t WS_H = WS_SSQA + (size_t)MROWS * 16 * 4;
constexpr size_t H_ROWS = 17000;
constexpr size_t WS_Z = WS_H + H_ROWS * DM * 2;
constexpr size_t WS_YG = WS_Z + (size_t)MROWS * ZP * 2;
constexpr size_t WS_MIX = WS_YG + (size_t)MROWS * DSSM * 2;
constexpr size_t WS_ACT = WS_Z;
constexpr size_t WS_XMID = WS_MIX + (size_t)MROWS * DM * 2;
constexpr size_t WS_END = WS_XMID + (size_t)MROWS * DM * 4;
static_assert(WS_ACT + (size_t)MROWS * DFF * 2 <= WS_XMID, "ACT overlay");
static_assert(WS_WGLU % 256 == 0 && WS_WOUT % 256 == 0 && WS_WUP % 256 == 0 && WS_WDOWN % 256 == 0 && WS_ROPE % 256 == 0 && WS_H % 256 == 0 && WS_Z % 256 == 0 && WS_XMID % 256 == 0, "align");

constexpr size_t O_YP = 0, O_YS = O_YP + (size_t)NB * SEQ * DM, O_PK = O_YS + (size_t)NS * DM, O_PV = O_PK + (size_t)NB * 128 * 256,
                 O_PRE = O_PV + (size_t)NB * 128 * 256, O_PIM = O_PRE + (size_t)NB * 64 * 64, O_PCONV = O_PIM + (size_t)NB * 64 * 64,
                 O_SK = O_PCONV + (size_t)NB * 2 * DFF2, O_SV = O_SK + (size_t)NS * 128 * 256, O_SRE = O_SV + (size_t)NS * 128 * 256,
                 O_SIM = O_SRE + (size_t)NS * 64 * 64, O_SCONV = O_SIM + (size_t)NS * 64 * 64, O_END = O_SCONV + (size_t)NS * 2 * DFF2;

constexpr int LDS_BYTES = 147456;

struct Args {
    const float* in[31];
    float* out;
    unsigned char* ws;
};

__device__ __forceinline__ unsigned f2bf(float f) { unsigned u = __builtin_bit_cast(unsigned, f); return (u + 0x7fffu + ((u >> 16) & 1u)) >> 16; }
typedef __bf16 bf16x2_t __attribute__((ext_vector_type(2)));
__device__ __forceinline__ unsigned pk2(float lo, float hi) { const f32x2 v = {lo, hi}; return __builtin_bit_cast(unsigned, __builtin_convertvector(v, bf16x2_t)); }
__device__ __forceinline__ float bf2f(unsigned short b) { return __builtin_bit_cast(float, (unsigned)b << 16); }
__device__ __forceinline__ float bflo(unsigned w) { return __builtin_bit_cast(float, w << 16); }
__device__ __forceinline__ float bfhi(unsigned w) { return __builtin_bit_cast(float, w & 0xffff0000u); }
__device__ __forceinline__ float wave_sum(float v) {
#pragma unroll
    for (int o = 1; o < 64; o <<= 1) v += __shfl_xor(v, o);
    return v;
}
__device__ __forceinline__ float wave_max(float v) {
#pragma unroll
    for (int o = 1; o < 64; o <<= 1) v = fmaxf(v, __shfl_xor(v, o));
    return v;
}
__device__ __forceinline__ void sincos_rev(double rev, float& s, float& c) {
    double r = rev - __builtin_floor(rev);
    double q = __builtin_floor(r * 4.0 + 0.5);
    double x = (r - q * 0.25) * 6.283185307179586476925;
    double x2 = x * x;
    double sp = x * (1.0 + x2 * (-1.0 / 6 + x2 * (1.0 / 120 + x2 * (-1.0 / 5040 + x2 * (1.0 / 362880 + x2 * (-1.0 / 39916800 + x2 * (1.0 / 6227020800.0)))))));
    double cp = 1.0 + x2 * (-0.5 + x2 * (1.0 / 24 + x2 * (-1.0 / 720 + x2 * (1.0 / 40320 + x2 * (-1.0 / 3628800 + x2 * (1.0 / 479001600 + x2 * (-1.0 / 87178291200.0)))))));
    int qi = ((int)q) & 3;
    double ss = (qi == 0) ? sp : (qi == 1) ? cp : (qi == 2) ? -sp : -cp;
    double cc = (qi == 0) ? cp : (qi == 1) ? -sp : (qi == 2) ? -cp : sp;
    s = (float)ss; c = (float)cc;
}
__device__ __forceinline__ float gelu_tanh(float y) {
    float z = 0.7978845608028654f * (y + 0.044715f * y * y * y);
    float e = __expf(2.0f * z);
    float th = 1.0f - 2.0f * __builtin_amdgcn_rcpf(e + 1.0f);
    return 0.5f * y * (1.0f + th);
}
__device__ __forceinline__ float sigmoidf_(float v) { return __builtin_amdgcn_rcpf(1.0f + __expf(-v)); }


typedef LAS unsigned long long* PTab;
__device__ __forceinline__ unsigned long long rfl64(unsigned long long v) { const unsigned lo = __builtin_amdgcn_readfirstlane((unsigned)v), hi = __builtin_amdgcn_readfirstlane((unsigned)(v >> 32)); return ((unsigned long long)hi << 32) | lo; }
#define GAS __attribute__((address_space(1)))
#define AIN(i) ((const float*)(const GAS float*)rfl64(a[(i)]))
#define AOUT ((float*)(GAS float*)rfl64(a[31]))
#define AWS ((unsigned char*)(GAS unsigned char*)rfl64(a[32]))

namespace pg8 {
constexpr int BM = 256, BK = 64, HALF = 128, HTB = HALF * BK * 2, STAGE_BYTES = 8 * HTB, NXCD = 8, WGM = 8;
__device__ __forceinline__ int lds_byte(int r, int c) { const int st = (r >> 4) * 2 + (c >> 5), rr = r & 15, cc = c & 31, ob = rr * 64 + cc * 2; return st * 1024 + (ob ^ (((ob >> 9) & 1) << 5)); }
__device__ __forceinline__ void stage_rc(int b, int& R, int& C) { const int st = b / 1024, sb = b % 1024, swz = sb ^ (((sb >> 9) & 1) << 5); R = (st >> 1) * 16 + swz / 64; C = (st & 1) * 32 + (swz % 64) / 2; }
__device__ __forceinline__ int perm32(int rho) { const int n = rho >> 4, i = rho & 15; return 8 * (i >> 2) + 4 * n + (i & 3); }

struct Unit { int pm, pn, k0, nk, sj, sc; };

template <int NM, int NN, int NT, bool SPLIT>
struct Order {
    static constexpr int nM = NM, nN = NN, nt = NT, nwg = NM * NN;
    int G, c;
    __device__ __forceinline__ void init(int G_, int c_) { G = G_; c = c_; }
    __device__ __forceinline__ int nfull() const { return SPLIT ? nwg - nwg % G : nwg; }
    __device__ __forceinline__ int cs() const { if (!SPLIT) return NT; const int R = nwg % G; if (R == 0) return NT; const int per = G / R; return 2 * (((NT / 2) + per - 1) / per); }
    __device__ __forceinline__ int nsplit() const { const int c_ = cs(); return (NT + c_ - 1) / c_; }
    __device__ __forceinline__ void map(int L, int& pm, int& pn) const {
        int wgid = L; { const int q = nwg / NXCD, r = nwg % NXCD, xcd = wgid % NXCD, off = wgid / NXCD; wgid = (xcd < r ? xcd * (q + 1) : r * (q + 1) + (xcd - r) * q) + off; }
        const int nig = WGM * nN, gid = wgid / nig, fm = gid * WGM, gsz = (nM - fm) < WGM ? (nM - fm) : WGM;
        pm = fm + ((wgid % nig) % gsz); pn = (wgid % nig) / gsz;
    }
    __device__ __forceinline__ int npieces() const { return SPLIT ? (nwg - nfull()) * nsplit() : 0; }
    __device__ __forceinline__ bool next(int i, Unit& u) const {
        const int nf = nfull(), np = npieces();
        const bool haspc = SPLIT && c < np;
        const bool ispc = haspc && i == 1;
        const int iw = (haspc && i >= 2) ? i - 1 : i;
        const int L = iw * G + c;
        const bool full = !ispc && L < nf;
        const int S = SPLIT ? nsplit() : 1, cs_ = SPLIT ? cs() : NT;
        const int p = c, sj = ispc ? p / S : 0, sc = ispc ? p - sj * S : 0;
        int pm, pn; map(ispc ? nf + sj : (full ? L : 0), pm, pn);
        const int k0 = ispc ? sc * cs_ : 0;
        const int nk = ispc ? ((NT - k0) < cs_ ? (NT - k0) : cs_) : NT;
        u = Unit{pm, pn, k0, nk, sj, sc};
        return ispc || full;
    }
    __device__ __forceinline__ bool piece(Unit& u) const { if (!(SPLIT && c < npieces())) return false; return next(1, u); }
};

__device__ __forceinline__ unsigned cvt_pk_bf16(float lo, float hi) { unsigned r; asm volatile("v_cvt_pk_bf16_f32 %0, %1, %2" : "=v"(r) : "v"(lo), "v"(hi)); return r; }

template <class Epi, bool ACHUNK, class Ord>
__device__ __forceinline__ void gemm_phase(LAS unsigned char* lds, const bf16_t* gA, const bf16_t* gBt, const Ord& S, const Epi& E) {
    int tid = threadIdx.x; asm volatile("" : "+v"(tid));
    const int wid = __builtin_amdgcn_readfirstlane(tid >> 6), lane = tid & 63, wr = wid >> 2, wc = wid & 3, fr = lane & 15, fq = lane >> 4;
    constexpr int K = Ord::nt * BK, ntot = Ord::nt;
    unsigned voffA[2], voffB[2];
#pragma unroll
    for (int i = 0; i < 2; ++i) { int R, C; stage_rc(tid * 16 + i * 8192, R, C); const int Rb = Epi::PERM ? ((R & ~31) + perm32(R & 31)) : R;
        const int Ra = ACHUNK ? (62 * (R >> 6) + (R & 63)) : R;
        voffA[i] = (unsigned)(Ra * K + C) * 2u; voffB[i] = (unsigned)(Rb * K + C) * 2u; }
    const size_t kstep = (size_t)(BK * 2);
    const size_t hsB = (size_t)HALF * K * 2, tsB = 2 * hsB;
    const size_t hsA = ACHUNK ? (size_t)124 * K * 2 : hsB, tsA = 2 * hsA;
    const unsigned ldsw = (unsigned)wid * 1024u;
    const int aoff = lds_byte(wr * 64 + fr, fq * 8), boff = lds_byte(wc * 32 + fr, fq * 8);
#define PG8_SA(b, h) (((b) * 2 + (h)) * HTB)
#define PG8_SB(b, h) ((4 + (b) * 2 + (h)) * HTB)
#define PG8_STAGE(bufoff, gbase, voff) do { _Pragma("unroll") for (int _i = 0; _i < 2; ++_i) \
        __builtin_amdgcn_global_load_lds((const unsigned*)((const char*)(gbase) + (voff)[_i]), (LAS unsigned*)(lds + (bufoff) + ldsw + _i * 8192), 16, 0, 0); } while (0)
#define PG8_LDA(dst, b, h) do { _Pragma("unroll") for (int m = 0; m < 4; ++m) _Pragma("unroll") for (int k = 0; k < 2; ++k) dst[m][k] = *(const LAS bf16x8*)(lds + PG8_SA(b, h) + aoff + m * 2048 + k * 1024); } while (0)
#define PG8_LDB(dst, b, h) do { _Pragma("unroll") for (int n = 0; n < 2; ++n) _Pragma("unroll") for (int k = 0; k < 2; ++k) dst[n][k] = *(const LAS bf16x8*)(lds + PG8_SB(b, h) + boff + n * 2048 + k * 1024); } while (0)
#define PG8_MMA(ai, bj, At, Bt) do { __builtin_amdgcn_s_setprio(1); _Pragma("unroll") for (int m = 0; m < 4; ++m) _Pragma("unroll") for (int n = 0; n < 2; ++n) _Pragma("unroll") for (int k = 0; k < 2; ++k) \
        acc[ai][bj][m][n] = __builtin_amdgcn_mfma_f32_16x16x32_bf16(Bt[n][k], At[m][k], acc[ai][bj][m][n], 0, 0, 0); __builtin_amdgcn_s_setprio(0); } while (0)
#define PG8_WAIT_V(n) asm volatile("s_waitcnt vmcnt(" #n ")" ::: "memory")
#define PG8_WAIT_L(n) asm volatile("s_waitcnt lgkmcnt(" #n ")" ::: "memory")
#define PG8_BAR __builtin_amdgcn_s_barrier()
#define PG8_SCHED __builtin_amdgcn_sched_barrier(0)
    Unit cur, nxt; int ui = 0;
    if (!S.next(0, cur)) return;
    f32x4 acc[2][2][4][2];
#pragma unroll
    for (int a = 0; a < 2; ++a)
#pragma unroll
        for (int b = 0; b < 2; ++b)
#pragma unroll
            for (int m = 0; m < 4; ++m)
#pragma unroll
                for (int n = 0; n < 2; ++n) acc[a][b][m][n] = (f32x4){0.f, 0.f, 0.f, 0.f};
    bf16x8 At[4][2], B0[2][2], B1[2][2];
    const char* cA = (const char*)gA + (size_t)cur.pm * tsA + (size_t)cur.k0 * kstep; const char* cB = (const char*)gBt + (size_t)cur.pn * tsB + (size_t)cur.k0 * kstep;
    PG8_STAGE(PG8_SB(0, 0), cB, voffB); PG8_STAGE(PG8_SB(0, 1), cB + hsB, voffB); PG8_STAGE(PG8_SA(0, 0), cA, voffA); PG8_STAGE(PG8_SA(0, 1), cA + hsA, voffA);
    if (wr == 1) PG8_BAR;
    PG8_WAIT_V(2); PG8_BAR;
    PG8_STAGE(PG8_SB(1, 0), cB + kstep, voffB); PG8_STAGE(PG8_SA(1, 0), cA + kstep, voffA); PG8_STAGE(PG8_SB(1, 1), cB + hsB + kstep, voffB);
    PG8_WAIT_V(6); PG8_BAR;
    for (;;) {
        const bool has_next = S.next(ui + 1, nxt);
        const char* nA = has_next ? (const char*)gA + (size_t)nxt.pm * tsA + (size_t)nxt.k0 * kstep : cA; const char* nB = has_next ? (const char*)gBt + (size_t)nxt.pn * tsB + (size_t)nxt.k0 * kstep : cB;
        const int nt = cur.nk;
        for (int t = 0; t < nt; t += 2) {
            const bool last = (t == nt - 2);
            const char* a1 = cA + (size_t)(t + 1) * kstep;
            const char* a2 = last ? nA : cA + (size_t)(t + 2) * kstep; const char* b2 = last ? nB : cB + (size_t)(t + 2) * kstep;
            const char* a3 = a2 + kstep; const char* b3 = b2 + kstep;
            if constexpr (Epi::MIDK) { if (t == ntot / 2 && nt == ntot) E.mid(acc, cur, wr, wc, fr, fq); }
            PG8_LDB(B0, 0, 0); PG8_LDB(B1, 0, 1); PG8_SCHED; PG8_LDA(At, 0, 0); PG8_STAGE(PG8_SA(1, 1), a1 + hsA, voffA);
            PG8_WAIT_V(8); PG8_WAIT_L(0); PG8_BAR; PG8_MMA(0, 0, At, B0); PG8_MMA(0, 1, At, B1); PG8_BAR; PG8_SCHED;
            PG8_LDA(At, 0, 1); PG8_STAGE(PG8_SB(0, 0), b2, voffB); PG8_STAGE(PG8_SB(0, 1), b2 + hsB, voffB); PG8_STAGE(PG8_SA(0, 0), a2, voffA);
            PG8_WAIT_V(8); PG8_WAIT_L(0); PG8_BAR; PG8_MMA(1, 0, At, B0); PG8_MMA(1, 1, At, B1); PG8_BAR; PG8_SCHED;
            PG8_LDB(B0, 1, 0); PG8_LDB(B1, 1, 1); PG8_SCHED; PG8_LDA(At, 1, 0); PG8_STAGE(PG8_SA(0, 1), a2 + hsA, voffA);
            PG8_WAIT_V(8); PG8_WAIT_L(0); PG8_BAR; PG8_MMA(0, 0, At, B0); PG8_MMA(0, 1, At, B1); PG8_BAR; PG8_SCHED;
            PG8_LDA(At, 1, 1); PG8_STAGE(PG8_SB(1, 0), b3, voffB); PG8_STAGE(PG8_SB(1, 1), b3 + hsB, voffB); PG8_STAGE(PG8_SA(1, 0), a3, voffA);
            PG8_WAIT_V(8); PG8_WAIT_L(0); PG8_BAR; PG8_MMA(1, 0, At, B0); PG8_MMA(1, 1, At, B1); PG8_BAR; PG8_SCHED;
        }
        if (wr == 0) PG8_BAR;
        E(acc, cur, wr, wc, fr, fq);
        if (!has_next) break;
#pragma unroll
        for (int a = 0; a < 2; ++a)
#pragma unroll
            for (int b = 0; b < 2; ++b)
#pragma unroll
                for (int m = 0; m < 4; ++m)
#pragma unroll
                    for (int n = 0; n < 2; ++n) acc[a][b][m][n] = (f32x4){0.f, 0.f, 0.f, 0.f};
        cur = nxt; cA = nA; cB = nB; ++ui;
        if (wr == 1) PG8_BAR;
    }
    PG8_WAIT_V(0);
    PG8_BAR;
#undef PG8_SA
#undef PG8_SB
#undef PG8_STAGE
#undef PG8_LDA
#undef PG8_LDB
#undef PG8_MMA
#undef PG8_WAIT_V
#undef PG8_WAIT_L
#undef PG8_BAR
#undef PG8_SCHED
}


__device__ __forceinline__ void store_wt(float* p, f32x4 v) {
    asm volatile("global_store_dwordx4 %0, %1, off sc1\n\ts_nop 1" :: "v"(p), "v"(v) : "memory");
}
__device__ __forceinline__ void part_rc(int idx, int& trow, int& tcol) {
    const int lane = idx & 63, wv = (idx >> 6) & 7, slot = idx >> 9, n = slot & 1, bj = (slot >> 1) & 1, m = (slot >> 2) & 3, ai = slot >> 4;
    trow = ai * 128 + (wv >> 2) * 64 + m * 16 + (lane & 15); tcol = bj * 128 + (wv & 3) * 32 + n * 16 + 4 * (lane >> 4);
}
__device__ __forceinline__ void split_publish(unsigned* cnt) {
    asm volatile("s_waitcnt vmcnt(0)" ::: "memory");
    __syncthreads();
    if (threadIdx.x == 0) __hip_atomic_fetch_add(cnt, 1u, __ATOMIC_RELAXED, __HIP_MEMORY_SCOPE_AGENT);
}
__device__ __forceinline__ void split_wait(unsigned* cnt, unsigned S) {
    if (threadIdx.x == 0) {
        unsigned sp = 0;
        while (__hip_atomic_load(cnt, __ATOMIC_RELAXED, __HIP_MEMORY_SCOPE_AGENT) < S) { __builtin_amdgcn_s_sleep(2); if (++sp > (1u << 22)) break; }
        __builtin_amdgcn_fence(__ATOMIC_ACQUIRE, "agent");
        asm volatile("s_waitcnt vmcnt(0)" ::: "memory");
    }
    __syncthreads();
}
struct EpiZ {
    static constexpr bool PERM = true, MIDK = false;
    PTab a;
    __device__ __forceinline__ void operator()(const f32x4 (&acc)[2][2][4][2], const Unit& u, int wr, int wc, int fr, int fq) const {
        bf16_t* O = (bf16_t*)(AWS + WS_Z); constexpr int ldc = ZP;
        const int row0 = u.pm * BM + wr * 64 + fr, col0 = u.pn * BM + wc * 32 + 8 * fq;
#pragma unroll
        for (int ai = 0; ai < 2; ++ai)
#pragma unroll
            for (int m = 0; m < 4; ++m) { bf16_t* rowp = O + (size_t)(row0 + ai * HALF + m * 16) * ldc + col0;
#pragma unroll
                for (int bj = 0; bj < 2; ++bj) { const f32x4 v0 = acc[ai][bj][m][0], v1 = acc[ai][bj][m][1];
                    u32x4 w; w.x = cvt_pk_bf16(v0[0], v0[1]); w.y = cvt_pk_bf16(v0[2], v0[3]); w.z = cvt_pk_bf16(v1[0], v1[1]); w.w = cvt_pk_bf16(v1[2], v1[3]);
                    *(u32x4*)(rowp + bj * HALF) = w; } }
    }
};
struct EpiGlu {
    static constexpr bool PERM = true, MIDK = false;
    PTab a; int S;
    __device__ __forceinline__ void operator()(const f32x4 (&acc)[2][2][4][2], const Unit& u, int wr, int wc, int fr, int fq) const {
        unsigned char* ws_ = AWS; const bf16_t* YG = (const bf16_t*)(ws_ + WS_YG); bf16_t* MIX = (bf16_t*)(ws_ + WS_MIX); const float* bglu = AIN(22); float* ssq = (float*)(ws_ + WS_SSQS);
        const int row0 = u.pm * BM + wr * 64 + fr, col0 = u.pn * BM + wc * 32 + 8 * fq;
        if (u.nk == DSSM / 64) {
#pragma unroll
        for (int ai = 0; ai < 2; ++ai)
#pragma unroll
            for (int m = 0; m < 4; ++m) { const int row = row0 + ai * HALF + m * 16; float ss = 0.f;
#pragma unroll
                for (int bj = 0; bj < 2; ++bj) { const int col = col0 + bj * HALF;
                    const u32x4 yv = *(const u32x4*)(YG + (size_t)row * DSSM + col);
                    const f32x4 b0 = *(const f32x4*)(bglu + col), b1 = *(const f32x4*)(bglu + col + 4);
                    const f32x4 v0 = acc[ai][bj][m][0] + b0, v1 = acc[ai][bj][m][1] + b1;
                    float o[8];
                    o[0] = bflo(yv.x) * sigmoidf_(v0[0]); o[1] = bfhi(yv.x) * sigmoidf_(v0[1]); o[2] = bflo(yv.y) * sigmoidf_(v0[2]); o[3] = bfhi(yv.y) * sigmoidf_(v0[3]);
                    o[4] = bflo(yv.z) * sigmoidf_(v1[0]); o[5] = bfhi(yv.z) * sigmoidf_(v1[1]); o[6] = bflo(yv.w) * sigmoidf_(v1[2]); o[7] = bfhi(yv.w) * sigmoidf_(v1[3]);
#pragma unroll
                    for (int e = 0; e < 8; ++e) ss += o[e] * o[e];
                    u32x4 w; w.x = cvt_pk_bf16(o[0], o[1]); w.y = cvt_pk_bf16(o[2], o[3]); w.z = cvt_pk_bf16(o[4], o[5]); w.w = cvt_pk_bf16(o[6], o[7]);
                    *(u32x4*)(MIX + (size_t)row * DM + col) = w; }
                ss += __shfl_xor(ss, 16); ss += __shfl_xor(ss, 32);
                if (fq == 0) unsafeAtomicAdd(ssq + row, ss); }
        } else {
            float* pt = (float*)(ws_ + WS_H) + ((size_t)(u.sj * S + u.sc) << 16) + 4 * (fr + 16 * fq) + 256 * (wr * 4 + wc);
#pragma unroll
            for (int ai = 0; ai < 2; ++ai)
#pragma unroll
                for (int m = 0; m < 4; ++m)
#pragma unroll
                    for (int bj = 0; bj < 2; ++bj)
#pragma unroll
                        for (int n = 0; n < 2; ++n) { store_wt(pt, acc[ai][bj][m][n]); pt += 2048; asm volatile("" : "+v"(pt)); }
            split_publish((unsigned*)(ws_ + WS_CTL + 16384 + 4096) + 64 * u.sj);
        }
    }
    __device__ __forceinline__ void finish(const Unit& u) const {
        unsigned char* ws_ = AWS; const bf16_t* YG = (const bf16_t*)(ws_ + WS_YG); bf16_t* MIX = (bf16_t*)(ws_ + WS_MIX); const float* bglu = AIN(22); float* ssq = (float*)(ws_ + WS_SSQS);
        split_wait((unsigned*)(ws_ + WS_CTL + 16384 + 4096) + 64 * u.sj, (unsigned)S);
        const int lo = u.sc * 16384 / S, hi = (u.sc + 1) * 16384 / S; const float* pb = (const float*)(ws_ + WS_H) + ((size_t)(u.sj * S) << 16);
        for (int idx = lo + (int)threadIdx.x; idx < hi; idx += 512) { f32x4 sum = (f32x4){0.f, 0.f, 0.f, 0.f};
            for (int c0 = 0; c0 < S; c0 += 8) {
                f32x4 pv[8];
#pragma unroll
                for (int k = 0; k < 8; ++k) pv[k] = (c0 + k < S) ? *(const f32x4*)(pb + ((size_t)(c0 + k) << 16) + 4 * idx) : (f32x4){0.f, 0.f, 0.f, 0.f};
#pragma unroll
                for (int k = 0; k < 8; ++k) sum += pv[k]; }
            const int lane = idx & 63, wv = (idx >> 6) & 7, slot = idx >> 9, n = slot & 1, bj = (slot >> 1) & 1, m = (slot >> 2) & 3, ai = slot >> 4;
            const int row = u.pm * BM + ai * 128 + (wv >> 2) * 64 + m * 16 + (lane & 15), col = u.pn * BM + bj * 128 + (wv & 3) * 32 + 8 * (lane >> 4) + 4 * n;
            const u32x2 yv = *(const u32x2*)(YG + (size_t)row * DSSM + col); const f32x4 bb = *(const f32x4*)(bglu + col); const f32x4 v = sum + bb;
            const float o0 = bflo(yv.x) * sigmoidf_(v[0]), o1 = bfhi(yv.x) * sigmoidf_(v[1]), o2 = bflo(yv.y) * sigmoidf_(v[2]), o3 = bfhi(yv.y) * sigmoidf_(v[3]);
            u32x2 w; w.x = pk2(o0, o1); w.y = pk2(o2, o3); *(u32x2*)(MIX + (size_t)row * DM + col) = w;
            unsafeAtomicAdd(ssq + row, (o0 * o0 + o1 * o1) + (o2 * o2 + o3 * o3)); }
    }
};
__device__ __forceinline__ float row_rs(const float* ssq, int row) { return 1.0f / sqrtf(ssq[row] * (1.0f / 1024.0f) + EPS); }
__device__ __forceinline__ const float* xrow_ptr(const float* xp, const float* xs, const float* meta, int row) {
    if (row >= NPR) return xs + (size_t)(row - NPR) * DM;
    const int b = row / TP, t = row - b * TP;
    return t < NMETA ? meta + (size_t)t * DM : xp + ((size_t)b * SEQ + (t - NMETA)) * DM;
}
struct EpiOut {
    static constexpr bool PERM = false, MIDK = true;
    PTab a; int S; unsigned char* wsp;
    __device__ __forceinline__ void mid(f32x4 (&acc)[2][2][4][2], const Unit& u, int wr, int wc, int fr, int fq) const {
        unsigned char* ws_ = wsp; const float* ssqS = (const float*)(ws_ + WS_SSQS); const float* ssqA = (const float*)(ws_ + WS_SSQA);
        int rowb = u.pm * BM + wr * 64 + fr; asm volatile("" : "+v"(rowb));
#pragma unroll
        for (int ai = 0; ai < 2; ++ai)
#pragma unroll
            for (int m = 0; m < 4; ++m) { const int row = rowb + ai * HALF + m * 16; float ratio = row_rs(ssqS, row) / row_rs(ssqA, row);
                asm volatile("" : "+v"(ratio) :: "memory");
#pragma unroll
                for (int bj = 0; bj < 2; ++bj)
#pragma unroll
                    for (int n = 0; n < 2; ++n) acc[ai][bj][m][n] *= ratio;
                asm volatile("" : "+v"(acc[ai][0][m][0]), "+v"(acc[ai][0][m][1]), "+v"(acc[ai][1][m][0]), "+v"(acc[ai][1][m][1]) :: "memory"); }
    }
    __device__ __forceinline__ void operator()(const f32x4 (&acc)[2][2][4][2], const Unit& u, int wr, int wc, int fr, int fq) const {
        unsigned char* ws_ = AWS; const float* ssqS = (const float*)(ws_ + WS_SSQS); const float* ssqA = (const float*)(ws_ + WS_SSQA); float* xmid = (float*)(ws_ + WS_XMID);
        float* part = (float*)(ws_ + WS_H); unsigned* cnt = (unsigned*)(ws_ + WS_CTL + 16384); const float *xp = AIN(0), *xs = AIN(1), *meta = AIN(7);
        const int tcol0 = wc * 32 + 4 * fq;
        const bool whole = u.nk == DM / 64;
        if (whole) {
#pragma unroll
            for (int ai = 0; ai < 2; ++ai)
#pragma unroll
                for (int m = 0; m < 4; ++m) { const int trow = ai * HALF + wr * 64 + m * 16 + fr, row = u.pm * BM + trow;
                    const float rsa = row_rs(ssqA, row);
                    const float* src = xrow_ptr(xp, xs, meta, row) + u.pn * BM; float* dst = xmid + (size_t)row * DM + u.pn * BM;
#pragma unroll
                    for (int bj = 0; bj < 2; ++bj)
#pragma unroll
                        for (int n = 0; n < 2; ++n) { const int tcol = tcol0 + bj * HALF + n * 16; const f32x4 xr = *(const f32x4*)(src + tcol); *(f32x4*)(dst + tcol) = xr + rsa * acc[ai][bj][m][n]; } }
        } else {
            float* pt = part + ((size_t)(u.sj * S + u.sc) << 16) + 4 * (fr + 16 * fq) + 256 * (wr * 4 + wc);
            const float* ssq = u.k0 >= DM / 128 ? ssqA : ssqS;
#pragma unroll
            for (int ai = 0; ai < 2; ++ai)
#pragma unroll
                for (int m = 0; m < 4; ++m) { const int row = u.pm * BM + ai * HALF + wr * 64 + m * 16 + fr; const float rsa = row_rs(ssq, row);
#pragma unroll
                    for (int bj = 0; bj < 2; ++bj)
#pragma unroll
                        for (int n = 0; n < 2; ++n) { const f32x4 v = rsa * acc[ai][bj][m][n]; store_wt(pt, v); pt += 2048; asm volatile("" : "+v"(pt)); } }
        }
        if (!whole) split_publish(cnt + 64 * u.sj);
    }
    __device__ __forceinline__ void finish(const Unit& u) const {
        unsigned char* ws_ = AWS; float* xmid = (float*)(ws_ + WS_XMID); float* part = (float*)(ws_ + WS_H); unsigned* cnt = (unsigned*)(ws_ + WS_CTL + 16384); const float *xp = AIN(0), *xs = AIN(1), *meta = AIN(7);
        split_wait(cnt + 64 * u.sj, (unsigned)S);
        const int lo = u.sc * 16384 / S, hi = (u.sc + 1) * 16384 / S; const float* pb = part + ((size_t)(u.sj * S) << 16);
        for (int idx = lo + (int)threadIdx.x; idx < hi; idx += 512) { f32x4 sum = (f32x4){0.f, 0.f, 0.f, 0.f};
            for (int c0 = 0; c0 < S; c0 += 12) {
                f32x4 pv[12];
#pragma unroll
                for (int k = 0; k < 12; ++k) pv[k] = (c0 + k < S) ? *(const f32x4*)(pb + ((size_t)(c0 + k) << 16) + 4 * idx) : (f32x4){0.f, 0.f, 0.f, 0.f};
#pragma unroll
                for (int k = 0; k < 12; ++k) sum += pv[k]; }
            int trow, tcol; part_rc(idx, trow, tcol); const int row = u.pm * BM + trow, col = u.pn * BM + tcol;
            *(f32x4*)(xmid + (size_t)row * DM + col) = sum + *(const f32x4*)(xrow_ptr(xp, xs, meta, row) + col); }
    }
};
struct EpiDown {
    static constexpr bool PERM = false, MIDK = false;
    PTab a; int S;
    __device__ __forceinline__ float* dst_row(float* out, int row) const {
        if (row >= NPR) return out + O_YS + (size_t)(row - NPR) * DM;
        const int b = row / TP, t = row - b * TP; return t < NMETA ? nullptr : out + O_YP + ((size_t)b * SEQ + (t - NMETA)) * DM;
    }
    __device__ __forceinline__ void operator()(const f32x4 (&acc)[2][2][4][2], const Unit& u, int wr, int wc, int fr, int fq) const {
        unsigned char* ws_ = AWS; const float* xmid = (const float*)(ws_ + WS_XMID); float* out = AOUT; float* part = (float*)(ws_ + WS_H); unsigned* cnt = (unsigned*)(ws_ + WS_CTL + 16384 + 8192);
        const int tcol0 = wc * 32 + 4 * fq;
        const bool whole = u.nk == DFF / 64;
        if (whole) {
#pragma unroll
            for (int ai = 0; ai < 2; ++ai)
#pragma unroll
                for (int m = 0; m < 4; ++m) { const int trow = ai * HALF + wr * 64 + m * 16 + fr, row = u.pm * BM + trow;
                    float* dst = dst_row(out, row);
                    if (!dst) continue;
                    const float* src = xmid + (size_t)row * DM + u.pn * BM;
#pragma unroll
                    for (int bj = 0; bj < 2; ++bj)
#pragma unroll
                        for (int n = 0; n < 2; ++n) { const int tcol = tcol0 + bj * HALF + n * 16; const f32x4 xr = *(const f32x4*)(src + tcol); *(f32x4*)(dst + u.pn * BM + tcol) = xr + acc[ai][bj][m][n]; } }
        } else {
            float* pt = part + ((size_t)(u.sj * S + u.sc) << 16) + 4 * (fr + 16 * fq) + 256 * (wr * 4 + wc);
#pragma unroll
            for (int ai = 0; ai < 2; ++ai)
#pragma unroll
                for (int m = 0; m < 4; ++m)
#pragma unroll
                    for (int bj = 0; bj < 2; ++bj)
#pragma unroll
                        for (int n = 0; n < 2; ++n) { store_wt(pt, acc[ai][bj][m][n]); pt += 2048; asm volatile("" : "+v"(pt)); }
        }
        if (!whole) split_publish(cnt + 64 * u.sj);
    }
    __device__ __forceinline__ void finish(const Unit& u) const {
        unsigned char* ws_ = AWS; const float* xmid = (const float*)(ws_ + WS_XMID); float* out = AOUT; float* part = (float*)(ws_ + WS_H); unsigned* cnt = (unsigned*)(ws_ + WS_CTL + 16384 + 8192);
        split_wait(cnt + 64 * u.sj, (unsigned)S);
        const int lo = u.sc * 16384 / S, hi = (u.sc + 1) * 16384 / S; const float* pb = part + ((size_t)(u.sj * S) << 16);
        for (int idx = lo + (int)threadIdx.x; idx < hi; idx += 512) { f32x4 sum = (f32x4){0.f, 0.f, 0.f, 0.f};
            for (int c0 = 0; c0 < S; c0 += 12) {
                f32x4 pv[12];
#pragma unroll
                for (int k = 0; k < 12; ++k) pv[k] = (c0 + k < S) ? *(const f32x4*)(pb + ((size_t)(c0 + k) << 16) + 4 * idx) : (f32x4){0.f, 0.f, 0.f, 0.f};
#pragma unroll
                for (int k = 0; k < 12; ++k) sum += pv[k]; }
            int trow, tcol; part_rc(idx, trow, tcol); const int row = u.pm * BM + trow, col = u.pn * BM + tcol;
            float* dst = dst_row(out, row);
            if (dst) *(f32x4*)(dst + col) = sum + *(const f32x4*)(xmid + (size_t)row * DM + col); }
    }
};
#define DPP_ROR1 0x121
#define DPP_ROR2 0x122
#define DPP_SHR1 0x111
#define DPP_SHR2 0x112
__device__ __forceinline__ float dppf(float old, float src, const int ctrl_sel) {
    const int o = __builtin_bit_cast(int, old), s = __builtin_bit_cast(int, src); int r;
    if (ctrl_sel == 0) r = __builtin_amdgcn_update_dpp(o, s, DPP_ROR1, 0xf, 0xf, true);
    else if (ctrl_sel == 1) r = __builtin_amdgcn_update_dpp(o, s, DPP_ROR2, 0xf, 0xf, true);
    else if (ctrl_sel == 2) r = __builtin_amdgcn_update_dpp(o, s, DPP_SHR1, 0xf, 0xf, false);
    else r = __builtin_amdgcn_update_dpp(o, s, DPP_SHR2, 0xf, 0xf, false);
    return __builtin_bit_cast(float, r);
}
struct EpiUp {
    static constexpr bool PERM = true, MIDK = false;
    PTab a;
    __device__ __forceinline__ void operator()(const f32x4 (&acc)[2][2][4][2], const Unit& u, int wr, int wc, int fr, int fq) const {
        const float *convw = AIN(28), *convb = AIN(29), *stconv = AIN(6); bf16_t* ACT = (bf16_t*)(AWS + WS_ACT); float* out = AOUT;
        const int colv0 = u.pn * 128 + wc * 32 + 8 * fq;
        int tt[2][4];
#pragma unroll
        for (int ai = 0; ai < 2; ++ai)
#pragma unroll
            for (int m = 0; m < 4; ++m) { const int row = u.pm * 248 + 62 * (2 * ai + wr) - 2 + 16 * m + fr;
                tt[ai][m] = ((m == 0 && fr < 2) || row >= MROWS) ? -1 : (row >= NPR ? (1 << 20) + (row - NPR) : row % TP); }
#pragma unroll
        for (int n = 0; n < 2; ++n) {
            const int cv = colv0 + 4 * n, cg_ = DFF + cv;
            const f32x4 w0v = *(const f32x4*)(convw + cv), w1v = *(const f32x4*)(convw + DFF2 + cv), w2v = *(const f32x4*)(convw + 2 * DFF2 + cv), bv = *(const f32x4*)(convb + cv);
            const f32x4 w0g = *(const f32x4*)(convw + cg_), w1g = *(const f32x4*)(convw + DFF2 + cg_), w2g = *(const f32x4*)(convw + 2 * DFF2 + cg_), bg = *(const f32x4*)(convb + cg_);
#pragma unroll
            for (int ai = 0; ai < 2; ++ai) {
                const int rbase = u.pm * 248 + 62 * (2 * ai + wr) - 2;
                f32x4 pvv = (f32x4){0.f, 0.f, 0.f, 0.f}, pvg = pvv;
#pragma unroll
                for (int m = 0; m < 4; ++m) {
                    const f32x4 cvv = acc[ai][0][m][n], cvg = acc[ai][1][m][n];
                    f32x4 p1v, p2v, p1g, p2g;
#pragma unroll
                    for (int e = 0; e < 4; ++e) {
                        p1v[e] = dppf(0.f, fr == 15 ? pvv[e] : cvv[e], 0); p2v[e] = dppf(0.f, fr >= 14 ? pvv[e] : cvv[e], 1);
                        p1g[e] = dppf(0.f, fr == 15 ? pvg[e] : cvg[e], 0); p2g[e] = dppf(0.f, fr >= 14 ? pvg[e] : cvg[e], 1);
                    }
                    pvv = cvv; pvg = cvg;
                    const int t = tt[ai][m];
                    if (t >= 0) {
                        const int row = rbase + 16 * m + fr;
                        if (t <= 1 || t >= TP - 2) {
                            if (t >= (1 << 20)) {
                                const int s = t - (1 << 20); const float* sc = stconv + (size_t)s * 2 * DFF2;
                                p2v = *(const f32x4*)(sc + cv); p1v = *(const f32x4*)(sc + DFF2 + cv); p2g = *(const f32x4*)(sc + cg_); p1g = *(const f32x4*)(sc + DFF2 + cg_);
                                float* so = out + O_SCONV + (size_t)s * 2 * DFF2;
                                *(f32x4*)(so + cv) = p1v; *(f32x4*)(so + cg_) = p1g; *(f32x4*)(so + DFF2 + cv) = cvv; *(f32x4*)(so + DFF2 + cg_) = cvg;
                            } else {
                                if (t == 0) { p1v = (f32x4){0.f, 0.f, 0.f, 0.f}; p1g = p1v; }
                                if (t <= 1) { p2v = (f32x4){0.f, 0.f, 0.f, 0.f}; p2g = p2v; }
                                if (t >= TP - 2) { const int b = row / TP; float* po = out + O_PCONV + ((size_t)b * 2 + (t - (TP - 2))) * DFF2; *(f32x4*)(po + cv) = cvv; *(f32x4*)(po + cg_) = cvg; }
                            }
                        }
                        const f32x4 cval = bv + w0v * p2v + w1v * p1v + w2v * cvv;
                        const f32x4 cgt = bg + w0g * p2g + w1g * p1g + w2g * cvg;
                        float o[4];
#pragma unroll
                        for (int e = 0; e < 4; ++e) o[e] = cgt[e] * sigmoidf_(cgt[e]) * cval[e];
                        u32x2 w; w.x = pk2(o[0], o[1]); w.y = pk2(o[2], o[3]);
                        *(u32x2*)(ACT + (size_t)row * DFF + cv) = w;
                    }
                }
            }
        }
    }
};
}

__device__ __forceinline__ void transpose_item(const float* W, int K, int N, bf16_t* WT, int mode, const float* ks0, const float* ks1, LAS float* scr, int item, int lane) {
    const int nblk = N / 32, kb = item / nblk, nb = item % nblk, k0 = 64 * kb, n0 = 32 * nb;
#pragma unroll 8
    for (int i = 0; i < 32; ++i) { const int kk = 2 * i + (lane >> 5); scr[kk * 33 + (lane & 31)] = W[(size_t)(k0 + kk) * N + n0 + (lane & 31)]; }
    asm volatile("s_waitcnt lgkmcnt(0)" ::: "memory");
    const int c = lane & 7;
    f32x4 ga = (f32x4){1.f, 1.f, 1.f, 1.f}, gb = ga;
    if (ks0) { const int k = k0 + 8 * c; const float* gp = k < 1024 ? ks0 + k : ks1 + (k - 1024); ga = *(const f32x4*)gp; gb = *(const f32x4*)(gp + 4); }
#pragma unroll
    for (int j = 0; j < 4; ++j) { const int n = (lane >> 3) + 8 * j; const LAS float* s = scr + (8 * c) * 33 + n;
        u32x4 o; o.x = pk2(s[0 * 33] * ga[0], s[1 * 33] * ga[1]); o.y = pk2(s[2 * 33] * ga[2], s[3 * 33] * ga[3]); o.z = pk2(s[4 * 33] * gb[0], s[5 * 33] * gb[1]); o.w = pk2(s[6 * 33] * gb[2], s[7 * 33] * gb[3]);
        const int col = n0 + n; int drow = col;
        if (mode == 1) { const int c2 = col < DFF ? col : col - DFF; drow = (c2 >> 7) * 256 + (col < DFF ? 0 : 128) + (c2 & 127); }
        *(u32x4*)(WT + (size_t)drow * K + k0 + 8 * c) = o; }
    asm volatile("s_waitcnt lgkmcnt(0)" ::: "memory");
}
__device__ __forceinline__ void rms_row_to_bf16(const float* xrow, const float* g, bf16_t* orow, int lane) {
    const f32x4* xr = (const f32x4*)xrow + lane; const f32x4* gr = (const f32x4*)g + lane;
    f32x4 v[8]; float s = 0.f;
#pragma unroll
    for (int j = 0; j < 8; ++j) { v[j] = xr[64 * j]; s += (v[j][0] * v[j][0] + v[j][1] * v[j][1]) + (v[j][2] * v[j][2] + v[j][3] * v[j][3]); }
    const float rstd = 1.0f / sqrtf(wave_sum(s) * (1.0f / DM) + EPS);
    u32x2* o8 = (u32x2*)orow + lane;
#pragma unroll
    for (int j = 0; j < 8; ++j) { const f32x4 gg = gr[64 * j]; u32x2 w; w.x = pk2(v[j][0] * rstd * gg[0], v[j][1] * rstd * gg[1]); w.y = pk2(v[j][2] * rstd * gg[2], v[j][3] * rstd * gg[3]); o8[64 * j] = w; }
}

__device__ __forceinline__ void s5_disc(const float* lam_re, const float* lam_im, int g, int p, float dt, float& are, float& aim, float& cre, float& cim) {
    const float lr = lam_re[g * 64 + p], li = lam_im[g * 64 + p];
    const float mag = expf(lr * dt);
    float sn, cs; sincos_rev((double)(li * dt) * 0.15915494309189533577, sn, cs);
    are = mag * cs; aim = mag * sn;
    const float den = lr * lr + li * li, am1 = are - 1.0f;
    cre = (am1 * lr + aim * li) / den; cim = (aim * lr - am1 * li) / den;
}

constexpr int SSM_WAVE_LDS = 12800 + 4096;
static_assert(8 * SSM_WAVE_LDS <= 146432, "SSM LDS vs the control words at the top of the allocation");
__device__ __forceinline__ void ssm_wave(const PTab a, LAS unsigned char* wl, bool sample, int bsel, int g, int lane) {
    const bf16_t* Z = (const bf16_t*)(AWS + WS_Z); bf16_t* YG = (bf16_t*)(AWS + WS_YG);
    const float *lam_re = AIN(13), *lam_im = AIN(14), *b_re = AIN(16), *b_im = AIN(17), *c_re = AIN(18), *c_im = AIN(19);
    LAS float* X = (LAS float*)wl; LAS bf16_t* Sb = (LAS bf16_t*)(wl + 8448);
    const int r16 = lane & 15, q4 = lane >> 4;
    const float dt = expf(AIN(15)[g]);
    float are, aim, tcr, tci; s5_disc(lam_re, lam_im, g, lane, dt, are, aim, tcr, tci);
    bf16x8 Bf[8];
#pragma unroll
    for (int blk = 0; blk < 8; ++blk) {
        const int p = 8 * blk + (r16 >> 1), c = r16 & 1;
        float d0, d1, cr, ci; s5_disc(lam_re, lam_im, g, p, dt, d0, d1, cr, ci);
        const float* br = b_re + ((size_t)g * 64 + p) * 16 + 8 * (q4 & 1); const float* bi = b_im + ((size_t)g * 64 + p) * 16 + 8 * (q4 & 1);
        bf16x8 f;
#pragma unroll
        for (int j = 0; j < 8; ++j) { const float v = c == 0 ? (cr * br[j] - ci * bi[j]) : (cr * bi[j] + ci * br[j]);
            const unsigned hi = f2bf(v); const float lo = v - __builtin_bit_cast(float, hi << 16);
            f[j] = (short)(q4 < 2 ? hi : f2bf(lo)); }
        Bf[blk] = f;
    }
    bf16x8 Cf[4];
#pragma unroll
    for (int kk = 0; kk < 4; ++kk) { bf16x8 f;
#pragma unroll
        for (int j = 0; j < 8; ++j) { const int p = 16 * kk + 4 * q4 + (j >> 1); const size_t ix = ((size_t)g * 16 + r16) * 64 + p;
            const float v = (j & 1) ? -c_im[ix] : c_re[ix]; f[j] = (short)f2bf(v); }
        Cf[kk] = f; }
    bf16x8 Df;
    { const float dsk = AIN(20)[g * 16 + r16]; const unsigned dhi = f2bf(dsk); const unsigned dlo = f2bf(dsk - __builtin_bit_cast(float, dhi << 16));
#pragma unroll
      for (int j = 0; j < 8; ++j) { const int kk = 8 * (q4 & 1) + j; Df[j] = (short)(kk == r16 ? (q4 < 2 ? dhi : dlo) : 0u); } }
    float sre = 0.f, sim = 0.f;
    const int nblk = sample ? 1 : TP / 16;
    const int rowbase = sample ? NPR + 16 * bsel : bsel * TP;
    const bf16_t* up = Z + (size_t)(rowbase + r16) * ZP + 16 * g + 8 * (q4 & 1);
    LAS bf16_t* Yb = (LAS bf16_t*)(wl + 12800);
    const int nch = (nblk + 7) / 8;
    bf16x8 Uc[8], Un[8];
#pragma unroll
    for (int i = 0; i < 8; ++i) { Uc[i] = (bf16x8){0, 0, 0, 0, 0, 0, 0, 0}; if (i < nblk) Uc[i] = *(const bf16x8*)(up + (size_t)(16 * i) * ZP); Un[i] = Uc[i]; }
    for (int ch = 0; ch < nch; ++ch) {
        const int nb = (nblk - 8 * ch) < 8 ? (nblk - 8 * ch) : 8;
        if (ch + 1 < nch) {
#pragma unroll
            for (int i = 0; i < 8; ++i) if (8 * (ch + 1) + i < nblk) Un[i] = *(const bf16x8*)(up + (size_t)(16 * (8 * (ch + 1) + i)) * ZP);
        }
#pragma unroll
        for (int i = 0; i < 8; ++i) {
            if (i < nb) {
                const bf16x8 Uf = Uc[i];
#pragma unroll
                for (int b8 = 0; b8 < 8; ++b8) {
                    f32x4 d = (f32x4){0.f, 0.f, 0.f, 0.f};
                    d = __builtin_amdgcn_mfma_f32_16x16x32_bf16(Bf[b8], Uf, d, 0, 0, 0);
                    *(LAS f32x4*)(X + r16 * 132 + 16 * b8 + 4 * q4) = d;
                }
                if (!sample) {
                    f32x2 xs[16];
#pragma unroll
                    for (int t = 0; t < 16; ++t) xs[t] = *(const LAS f32x2*)(X + t * 132 + 2 * lane);
#pragma unroll
                    for (int t = 0; t < 16; ++t) {
                        const float nr = are * sre - aim * sim + xs[t][0], ni = are * sim + aim * sre + xs[t][1];
                        sre = nr; sim = ni;
                        *(LAS unsigned*)(Sb + t * 136 + 2 * lane) = pk2(nr, ni);
                    }
                } else {
                    for (int t = 0; t < 16; ++t) {
                        const int s = 16 * bsel + t; const size_t ix = ((size_t)s * 64 + g) * 64 + lane;
                        const float h0r = AIN(4)[ix], h0i = AIN(5)[ix];
                        const f32x2 x = *(const LAS f32x2*)(X + t * 132 + 2 * lane);
                        const float nr = are * h0r - aim * h0i + x[0], ni = are * h0i + aim * h0r + x[1];
                        AOUT[O_SRE + ix] = nr; AOUT[O_SIM + ix] = ni;
                        *(LAS unsigned*)(Sb + t * 136 + 2 * lane) = pk2(nr, ni);
                    }
                }
                f32x4 y = (f32x4){0.f, 0.f, 0.f, 0.f};
                y = __builtin_amdgcn_mfma_f32_16x16x32_bf16(Uf, Df, y, 0, 0, 0);
#pragma unroll
                for (int kk = 0; kk < 4; ++kk) { const bf16x8 Af = *(const LAS bf16x8*)(Sb + r16 * 136 + 32 * kk + 8 * q4); y = __builtin_amdgcn_mfma_f32_16x16x32_bf16(Af, Cf[kk], y, 0, 0, 0); }
#pragma unroll
                for (int r = 0; r < 4; ++r) Yb[(16 * i + 4 * q4 + r) * 16 + r16] = (bf16_t)(pk2(gelu_tanh(y[r]), 0.f) & 0xffffu);
            }
        }
#pragma unroll
        for (int k = 0; k < 4; ++k) { const int rr = (lane >> 1) + 32 * k;
            if (rr < 16 * nb) *(u32x4*)(YG + (size_t)(rowbase + 128 * ch + rr) * DSSM + 16 * g + 8 * (lane & 1)) = *(const LAS u32x4*)(Yb + rr * 16 + 8 * (lane & 1)); }
#pragma unroll
        for (int i = 0; i < 8; ++i) Uc[i] = Un[i];
    }
    if (!sample) { const size_t ix = ((size_t)bsel * 64 + g) * 64 + lane; AOUT[O_PRE + ix] = sre; AOUT[O_PIM + ix] = sim; }
}


constexpr int PAIR_LDS = 8448 + 4 * 4352 + 4096 + 64;
constexpr int PAIR_RING = 8448, PAIR_YB = 8448 + 4 * 4352, PAIR_FLG = PAIR_YB + 4096;
static_assert(4 * PAIR_LDS <= 146432, "S5 pair regions vs the control words at the top of the allocation");
__device__ __forceinline__ void ssm_scan_role(const PTab a, LAS unsigned char* pl, int b, int g, int lane) {
    const bf16_t* Z = (const bf16_t*)(AWS + WS_Z);
    const float *lam_re = AIN(13), *lam_im = AIN(14), *b_re = AIN(16), *b_im = AIN(17);
    LAS float* X = (LAS float*)pl; volatile LAS unsigned* flg = (volatile LAS unsigned*)(pl + PAIR_FLG);
    const int r16 = lane & 15, q4 = lane >> 4;
    const float dt = expf(AIN(15)[g]);
    float are, aim, tcr, tci; s5_disc(lam_re, lam_im, g, lane, dt, are, aim, tcr, tci);
    bf16x8 Bf[8];
#pragma unroll
    for (int blk = 0; blk < 8; ++blk) {
        const int p = 8 * blk + (r16 >> 1), c = r16 & 1;
        float d0, d1, cr, ci; s5_disc(lam_re, lam_im, g, p, dt, d0, d1, cr, ci);
        const float* br = b_re + ((size_t)g * 64 + p) * 16 + 8 * (q4 & 1); const float* bi = b_im + ((size_t)g * 64 + p) * 16 + 8 * (q4 & 1);
        bf16x8 f;
#pragma unroll
        for (int j = 0; j < 8; ++j) { const float v = c == 0 ? (cr * br[j] - ci * bi[j]) : (cr * bi[j] + ci * br[j]);
            const unsigned hi = f2bf(v); const float lo = v - __builtin_bit_cast(float, hi << 16);
            f[j] = (short)(q4 < 2 ? hi : f2bf(lo)); }
        Bf[blk] = f;
    }
    float sre = 0.f, sim = 0.f;
    constexpr int nblk = TP / 16, nch = (nblk + 7) / 8;
    const int rowbase = b * TP;
    const bf16_t* up = Z + (size_t)(rowbase + r16) * ZP + 16 * g + 8 * (q4 & 1);
    bf16x8 Uc[8], Un[8];
#pragma unroll
    for (int i = 0; i < 8; ++i) { Uc[i] = *(const bf16x8*)(up + (size_t)(16 * i) * ZP); Un[i] = Uc[i]; }
    for (int ch = 0; ch < nch; ++ch) {
        const int nb = (nblk - 8 * ch) < 8 ? (nblk - 8 * ch) : 8;
        if (ch + 1 < nch) {
#pragma unroll
            for (int i = 0; i < 8; ++i) if (8 * (ch + 1) + i < nblk) Un[i] = *(const bf16x8*)(up + (size_t)(16 * (8 * (ch + 1) + i)) * ZP);
        }
#pragma unroll
        for (int i = 0; i < 8; ++i) {
            if (i < nb) {
                const int blk = 8 * ch + i;
#pragma unroll
                for (int b8 = 0; b8 < 8; ++b8) {
                    f32x4 d = (f32x4){0.f, 0.f, 0.f, 0.f};
                    d = __builtin_amdgcn_mfma_f32_16x16x32_bf16(Bf[b8], Uc[i], d, 0, 0, 0);
                    *(LAS f32x4*)(X + r16 * 132 + 16 * b8 + 4 * q4) = d;
                }
                f32x2 xs[16];
#pragma unroll
                for (int t = 0; t < 16; ++t) xs[t] = *(const LAS f32x2*)(X + t * 132 + 2 * lane);
                if (blk >= 4) { unsigned sp = 0; while (flg[1] < (unsigned)(blk - 3)) { __builtin_amdgcn_s_sleep(1); if (++sp > (1u << 22)) break; } }
                asm volatile("" ::: "memory");
                LAS bf16_t* Sw = (LAS bf16_t*)(pl + PAIR_RING + (i & 3) * 4352);
#pragma unroll
                for (int t = 0; t < 16; ++t) {
                    const float nr = are * sre - aim * sim + xs[t][0], ni = are * sim + aim * sre + xs[t][1];
                    sre = nr; sim = ni;
                    *(LAS unsigned*)(Sw + t * 136 + 2 * lane) = pk2(nr, ni);
                }
                asm volatile("s_waitcnt lgkmcnt(0)" ::: "memory");
                if (lane == 0) flg[0] = (unsigned)(blk + 1);
            }
        }
#pragma unroll
        for (int i = 0; i < 8; ++i) Uc[i] = Un[i];
    }
    { const size_t ix = ((size_t)b * 64 + g) * 64 + lane; AOUT[O_PRE + ix] = sre; AOUT[O_PIM + ix] = sim; }
}
__device__ __forceinline__ void ssm_out_role(const PTab a, LAS unsigned char* pl, int b, int g, int lane) {
    const bf16_t* Z = (const bf16_t*)(AWS + WS_Z); bf16_t* YG = (bf16_t*)(AWS + WS_YG);
    const float *c_re = AIN(18), *c_im = AIN(19);
    volatile LAS unsigned* flg = (volatile LAS unsigned*)(pl + PAIR_FLG); LAS bf16_t* Yb = (LAS bf16_t*)(pl + PAIR_YB);
    const int r16 = lane & 15, q4 = lane >> 4;
    bf16x8 Cf[4];
#pragma unroll
    for (int kk = 0; kk < 4; ++kk) { bf16x8 f;
#pragma unroll
        for (int j = 0; j < 8; ++j) { const int p = 16 * kk + 4 * q4 + (j >> 1); const size_t ix = ((size_t)g * 16 + r16) * 64 + p;
            const float v = (j & 1) ? -c_im[ix] : c_re[ix]; f[j] = (short)f2bf(v); }
        Cf[kk] = f; }
    bf16x8 Df;
    { const float dsk = AIN(20)[g * 16 + r16]; const unsigned dhi = f2bf(dsk); const unsigned dlo = f2bf(dsk - __builtin_bit_cast(float, dhi << 16));
#pragma unroll
      for (int j = 0; j < 8; ++j) { const int kk = 8 * (q4 & 1) + j; Df[j] = (short)(kk == r16 ? (q4 < 2 ? dhi : dlo) : 0u); } }
    constexpr int nblk = TP / 16, nch = (nblk + 7) / 8;
    const int rowbase = b * TP;
    const bf16_t* up = Z + (size_t)(rowbase + r16) * ZP + 16 * g + 8 * (q4 & 1);
    bf16x8 Uc[8], Un[8];
#pragma unroll
    for (int i = 0; i < 8; ++i) { Uc[i] = *(const bf16x8*)(up + (size_t)(16 * i) * ZP); Un[i] = Uc[i]; }
    for (int ch = 0; ch < nch; ++ch) {
        const int nb = (nblk - 8 * ch) < 8 ? (nblk - 8 * ch) : 8;
        if (ch + 1 < nch) {
#pragma unroll
            for (int i = 0; i < 8; ++i) if (8 * (ch + 1) + i < nblk) Un[i] = *(const bf16x8*)(up + (size_t)(16 * (8 * (ch + 1) + i)) * ZP);
        }
#pragma unroll
        for (int i = 0; i < 8; ++i) {
            if (i < nb) {
                const int blk = 8 * ch + i;
                { unsigned sp = 0; while (flg[0] < (unsigned)(blk + 1)) { __builtin_amdgcn_s_sleep(1); if (++sp > (1u << 22)) break; } }
                asm volatile("" ::: "memory");
                const LAS bf16_t* Sr = (const LAS bf16_t*)(pl + PAIR_RING + (i & 3) * 4352);
                bf16x8 Af[4];
#pragma unroll
                for (int kk = 0; kk < 4; ++kk) Af[kk] = *(const LAS bf16x8*)(Sr + r16 * 136 + 32 * kk + 8 * q4);
                asm volatile("s_waitcnt lgkmcnt(0)" ::: "memory");
                if (lane == 0) flg[1] = (unsigned)(blk + 1);
                f32x4 y = (f32x4){0.f, 0.f, 0.f, 0.f};
                y = __builtin_amdgcn_mfma_f32_16x16x32_bf16(Uc[i], Df, y, 0, 0, 0);
#pragma unroll
                for (int kk = 0; kk < 4; ++kk) y = __builtin_amdgcn_mfma_f32_16x16x32_bf16(Af[kk], Cf[kk], y, 0, 0, 0);
#pragma unroll
                for (int r = 0; r < 4; ++r) Yb[(16 * i + 4 * q4 + r) * 16 + r16] = (bf16_t)(pk2(gelu_tanh(y[r]), 0.f) & 0xffffu);
            }
        }
#pragma unroll
        for (int k = 0; k < 4; ++k) { const int rr = (lane >> 1) + 32 * k;
            if (rr < 16 * nb) *(u32x4*)(YG + (size_t)(rowbase + 128 * ch + rr) * DSSM + 16 * g + 8 * (lane & 1)) = *(const LAS u32x4*)(Yb + rr * 16 + 8 * (lane & 1)); }
#pragma unroll
        for (int i = 0; i < 8; ++i) Uc[i] = Un[i];
    }
}

__device__ __forceinline__ void attn_prompt_unit(const PTab a, LAS unsigned char* lds, int b, int kh, int qb, int tid) {
    const bf16_t* Z = (const bf16_t*)(AWS + WS_Z); bf16_t* MIX = (bf16_t*)(AWS + WS_MIX); float* ssqA = (float*)(AWS + WS_SSQA);
    const f32x2* rope = (const f32x2*)(AWS + WS_ROPE);
    const float *qg = AIN(10), *kg = AIN(11);
    LAS bf16_t* KT = (LAS bf16_t*)lds; LAS bf16_t* VT = (LAS bf16_t*)(lds + 27648);
    const int t0 = qb * 64, tk0 = t0 - 128;
    const int wave = tid >> 6, lane = tid & 63;
    const int head = kh * 4 + (wave & 3), half = wave >> 2, r32 = lane & 31, hf = lane >> 5;
    const int tq0 = t0 + 32 * half, tq = tq0 + r32; const bool qvalid = tq < TP;
    const int qrow = b * TP + (qvalid ? tq : TP - 1);
    u32x4 qraw[4];
    { const bf16_t* qp = Z + (size_t)qrow * ZP + 1024 + head * 64 + 8 * hf;
#pragma unroll
      for (int ks = 0; ks < 4; ++ks) qraw[ks] = *(const u32x4*)(qp + 16 * ks); }
    __syncthreads();
#pragma unroll 1
    for (int pass = 0; pass < 3; ++pass) {
        const int idx = pass * 512 + tid, key = idx >> 3, i = idx & 7, t = tk0 + key; const bool valid = t >= 0 && t < TP;
        u32x2 r1 = (u32x2){0u, 0u}, r2 = r1;
        if (valid) { const bf16_t* kp = Z + (size_t)(b * TP + t) * ZP + 2048 + kh * 64; r1 = *(const u32x2*)(kp + 4 * i); r2 = *(const u32x2*)(kp + 32 + 4 * i); }
        float x1[4] = {bflo(r1.x), bfhi(r1.x), bflo(r1.y), bfhi(r1.y)}, x2[4] = {bflo(r2.x), bfhi(r2.x), bflo(r2.y), bfhi(r2.y)};
        float ss = 0.f;
#pragma unroll
        for (int e = 0; e < 4; ++e) ss += x1[e] * x1[e] + x2[e] * x2[e];
        ss += __shfl_xor(ss, 1); ss += __shfl_xor(ss, 2); ss += __shfl_xor(ss, 4);
        const float rstd = 1.0f / sqrtf(ss * (1.0f / 64.0f) + EPS);
        float o1[4], o2[4];
        const f32x4* rp = (const f32x4*)(rope + (size_t)(valid ? t : 0) * 32 + 4 * i);
        const f32x4 ra = rp[0], rb = rp[1]; const float cs_c[4] = {ra[0], ra[2], rb[0], rb[2]}, cs_s[4] = {ra[1], ra[3], rb[1], rb[3]};
        const f32x4 g1 = *(const f32x4*)(kg + 4 * i), g2 = *(const f32x4*)(kg + 32 + 4 * i);
#pragma unroll
        for (int e = 0; e < 4; ++e) {
            const float y1 = x1[e] * rstd * g1[e], y2 = x2[e] * rstd * g2[e];
            o1[e] = y1 * cs_c[e] - y2 * cs_s[e]; o2[e] = y1 * cs_s[e] + y2 * cs_c[e]; }
        u32x2 w1, w2; w1.x = pk2(o1[0], o1[1]); w1.y = pk2(o1[2], o1[3]); w2.x = pk2(o2[0], o2[1]); w2.y = pk2(o2[2], o2[3]);
        *(LAS u32x2*)(KT + key * 72 + 4 * i) = w1; *(LAS u32x2*)(KT + key * 72 + 32 + 4 * i) = w2;
        if (valid && key >= 128 && t >= TP - 128) { float* po = AOUT + O_PK + (((size_t)b * 128 + (t - (TP - 128))) * 4 + kh) * 64;
            *(f32x4*)(po + 4 * i) = (f32x4){o1[0], o1[1], o1[2], o1[3]}; *(f32x4*)(po + 32 + 4 * i) = (f32x4){o2[0], o2[1], o2[2], o2[3]}; }
    }
#pragma unroll 1
    for (int pass = 0; pass < 3; ++pass) {
        const int idx = pass * 512 + tid, key = idx >> 3, j = idx & 7, t = tk0 + key; const bool valid = t >= 0 && t < TP;
        u32x4 r = (u32x4){0u, 0u, 0u, 0u};
        if (valid) r = *(const u32x4*)(Z + (size_t)(b * TP + t) * ZP + 2304 + kh * 64 + 8 * j);
        const unsigned w[4] = {r.x, r.y, r.z, r.w};
#pragma unroll
        for (int e = 0; e < 4; ++e) { VT[(8 * j + 2 * e) * 200 + key] = (bf16_t)(w[e] & 0xffffu); VT[(8 * j + 2 * e + 1) * 200 + key] = (bf16_t)(w[e] >> 16); }
        if (valid && key >= 128 && t >= TP - 128) { float* po = AOUT + O_PV + (((size_t)b * 128 + (t - (TP - 128))) * 4 + kh) * 64 + 8 * j;
            *(f32x4*)(po) = (f32x4){bflo(r.x), bfhi(r.x), bflo(r.y), bfhi(r.y)}; *(f32x4*)(po + 4) = (f32x4){bflo(r.z), bfhi(r.z), bflo(r.w), bfhi(r.w)}; }
    }
    __syncthreads();
    float qv[4][8];
    { float ss = 0.f;
#pragma unroll
      for (int ks = 0; ks < 4; ++ks) { const u32x4 r = qraw[ks];
          qv[ks][0] = bflo(r.x); qv[ks][1] = bfhi(r.x); qv[ks][2] = bflo(r.y); qv[ks][3] = bfhi(r.y); qv[ks][4] = bflo(r.z); qv[ks][5] = bfhi(r.z); qv[ks][6] = bflo(r.w); qv[ks][7] = bfhi(r.w);
#pragma unroll
          for (int j = 0; j < 8; ++j) ss += qv[ks][j] * qv[ks][j]; }
      ss += __shfl_xor(ss, 32);
      const float rstd = 0.125f / sqrtf(ss * (1.0f / 64.0f) + EPS);
#pragma unroll
      for (int ks = 0; ks < 2; ++ks) {
          const f32x4* rp = (const f32x4*)(rope + (size_t)(qvalid ? tq : TP - 1) * 32 + 16 * ks + 8 * hf);
          const f32x4* gp1 = (const f32x4*)(qg + 16 * ks + 8 * hf); const f32x4* gp2 = (const f32x4*)(qg + 32 + 16 * ks + 8 * hf);
#pragma unroll
          for (int jj = 0; jj < 4; ++jj) { const f32x4 cs2 = rp[jj]; const f32x4 ga = gp1[jj >> 1], gb = gp2[jj >> 1];
#pragma unroll
              for (int e = 0; e < 2; ++e) { const int j = 2 * jj + e; const float c = cs2[2 * e], sn = cs2[2 * e + 1];
                  const float y1 = qv[ks][j] * rstd * ga[(j & 3)], y2 = qv[ks + 2][j] * rstd * gb[(j & 3)];
                  qv[ks][j] = y1 * c - y2 * sn; qv[ks + 2][j] = y1 * sn + y2 * c; } } } }
    bf16x8 qf[4];
#pragma unroll
    for (int ks = 0; ks < 4; ++ks)
#pragma unroll
        for (int j = 0; j < 8; ++j) qf[ks][j] = (short)f2bf(qv[ks][j]);
    const int wk0 = 32 * half;
    const float sink = AIN(12)[head];
    float mx = sink;
#pragma unroll 1
    for (int kb = 0; kb < 5; ++kb) {
        f32x16 s;
#pragma unroll
        for (int r = 0; r < 16; ++r) s[r] = 0.f;
#pragma unroll
        for (int ks = 0; ks < 4; ++ks) { const bf16x8 kf = *(const LAS bf16x8*)(KT + (wk0 + 32 * kb + r32) * 72 + 16 * ks + 8 * hf);
            s = __builtin_amdgcn_mfma_f32_32x32x16_bf16(kf, qf[ks], s, 0, 0, 0); }
#pragma unroll
        for (int r = 0; r < 16; ++r) { const int i = (r & 3) + 8 * (r >> 2) + 4 * hf; const int diff = 128 + r32 - 32 * kb - i; const int kp = tq - diff;
            const bool ok = diff >= 0 && diff < 128 && kp >= 0; mx = fmaxf(mx, ok ? s[r] : -1e30f); }
    }
    mx = fmaxf(mx, __shfl_xor(mx, 32));
    float lsum = 0.f;
    f32x16 oacc[2];
#pragma unroll
    for (int db = 0; db < 2; ++db)
#pragma unroll
        for (int r = 0; r < 16; ++r) oacc[db][r] = 0.f;
#pragma unroll 1
    for (int kb = 0; kb < 5; ++kb) {
        f32x16 s;
#pragma unroll
        for (int r = 0; r < 16; ++r) s[r] = 0.f;
#pragma unroll
        for (int ks = 0; ks < 4; ++ks) { const bf16x8 kf = *(const LAS bf16x8*)(KT + (wk0 + 32 * kb + r32) * 72 + 16 * ks + 8 * hf);
            s = __builtin_amdgcn_mfma_f32_32x32x16_bf16(kf, qf[ks], s, 0, 0, 0); }
#pragma unroll
        for (int r = 0; r < 16; ++r) { const int i = (r & 3) + 8 * (r >> 2) + 4 * hf; const int diff = 128 + r32 - 32 * kb - i; const int kp = tq - diff;
            const bool ok = diff >= 0 && diff < 128 && kp >= 0; const float p = ok ? __expf(s[r] - mx) : 0.f; s[r] = p; lsum += p; }
#pragma unroll
        for (int s2 = 0; s2 < 2; ++s2) {
            bf16x8 pf;
#pragma unroll
            for (int j = 0; j < 8; ++j) pf[j] = (short)f2bf(s[8 * s2 + j]);
#pragma unroll
            for (int db = 0; db < 2; ++db) {
                const LAS bf16_t* vp = VT + (32 * db + r32) * 200 + wk0 + 32 * kb + 16 * s2 + 4 * hf;
                const u32x2 v0 = *(const LAS u32x2*)vp, v1 = *(const LAS u32x2*)(vp + 8);
                u32x4 vv; vv.x = v0.x; vv.y = v0.y; vv.z = v1.x; vv.w = v1.y;
                oacc[db] = __builtin_amdgcn_mfma_f32_32x32x16_bf16(__builtin_bit_cast(bf16x8, vv), pf, oacc[db], 0, 0, 0);
            }
        }
    }
    lsum += __shfl_xor(lsum, 32);
    lsum += __expf(sink - mx);
    const float inv = 1.0f / lsum; float ss = 0.f;
#pragma unroll
    for (int db = 0; db < 2; ++db)
#pragma unroll
        for (int r = 0; r < 16; ++r) { const float o = oacc[db][r] * inv; oacc[db][r] = o; ss += o * o; }
    ss += __shfl_xor(ss, 32);
    if (qvalid) {
        bf16_t* op = MIX + (size_t)qrow * DM + 1024 + head * 64;
#pragma unroll
        for (int db = 0; db < 2; ++db)
#pragma unroll
            for (int g4 = 0; g4 < 4; ++g4) { u32x2 w; w.x = pk2(oacc[db][4 * g4], oacc[db][4 * g4 + 1]); w.y = pk2(oacc[db][4 * g4 + 2], oacc[db][4 * g4 + 3]);
                *(u32x2*)(op + 32 * db + 8 * g4 + 4 * hf) = w; }
        if (hf == 0) unsafeAtomicAdd(ssqA + qrow, ss);
    }
}

__device__ __forceinline__ void attn_sample_unit(const PTab a, LAS unsigned char* lds, int s, int tid) {
    const bf16_t* Z = (const bf16_t*)(AWS + WS_Z); bf16_t* MIX = (bf16_t*)(AWS + WS_MIX); float* ssqA = (float*)(AWS + WS_SSQA);
    const f32x2* rope = (const f32x2*)(AWS + WS_ROPE) + (size_t)TP * 32;
    LAS float* qs = (LAS float*)lds;
    LAS float* kn = qs + 1024;
    LAS float* vn = kn + 256;
    LAS float* sc = vn + 256;
    LAS float* red = sc + 2048;
    const int wave = tid >> 6, lane = tid & 63, row = NPR + s;
    const bf16_t* zr = Z + (size_t)row * ZP;
    __syncthreads();
    const f32x2 cs = rope[lane & 31];
#pragma unroll 1
    for (int hh = 0; hh < 2; ++hh) { const int h = 2 * wave + hh; const float v = bf2f(zr[1024 + h * 64 + lane]);
        const float rstd = 1.0f / sqrtf(wave_sum(v * v) * (1.0f / 64.0f) + EPS); const float x = v * rstd * AIN(10)[lane]; const float pr = __shfl_xor(x, 32);
        const float o = lane < 32 ? x * cs[0] - pr * cs[1] : pr * cs[1] + x * cs[0]; qs[h * 64 + lane] = o * 0.125f; }
    if (wave < 4) { const int kh = wave; const float v = bf2f(zr[2048 + kh * 64 + lane]);
        const float rstd = 1.0f / sqrtf(wave_sum(v * v) * (1.0f / 64.0f) + EPS); const float x = v * rstd * AIN(11)[lane]; const float pr = __shfl_xor(x, 32);
        const float o = lane < 32 ? x * cs[0] - pr * cs[1] : pr * cs[1] + x * cs[0]; kn[kh * 64 + lane] = o;
        AOUT[O_SK + (((size_t)s * 128 + 127) * 4 + kh) * 64 + lane] = o;
        const float vv = bf2f(zr[2304 + kh * 64 + lane]); vn[kh * 64 + lane] = vv; AOUT[O_SV + (((size_t)s * 128 + 127) * 4 + kh) * 64 + lane] = vv; }
    __syncthreads();
    { const int j = tid & 127, kh = tid >> 7; float acc4[4] = {0.f, 0.f, 0.f, 0.f};
      const float* kp = AIN(2) + (((size_t)s * 128 + (j < 127 ? j + 1 : 127)) * 4 + kh) * 64;
#pragma unroll 4
      for (int d4 = 0; d4 < 16; ++d4) { f32x4 kv; if (j < 127) kv = *(const f32x4*)(kp + 4 * d4); else kv = *(const LAS f32x4*)(kn + kh * 64 + 4 * d4);
#pragma unroll
          for (int hq = 0; hq < 4; ++hq) { const f32x4 q = *(const LAS f32x4*)(qs + (kh * 4 + hq) * 64 + 4 * d4); acc4[hq] += (kv[0] * q[0] + kv[1] * q[1]) + (kv[2] * q[2] + kv[3] * q[3]); } }
#pragma unroll
      for (int hq = 0; hq < 4; ++hq) sc[(kh * 4 + hq) * 128 + j] = acc4[hq]; }
    __syncthreads();
#pragma unroll 1
    for (int hh = 0; hh < 2; ++hh) { const int h = 2 * wave + hh; const float v0 = sc[h * 128 + lane], v1 = sc[h * 128 + 64 + lane]; const float sink = AIN(12)[h];
        const float m = fmaxf(wave_max(fmaxf(v0, v1)), sink); const float p0 = __expf(v0 - m), p1 = __expf(v1 - m);
        const float inv = 1.0f / (wave_sum(p0 + p1) + __expf(sink - m)); sc[h * 128 + lane] = p0 * inv; sc[h * 128 + 64 + lane] = p1 * inv; }
    __syncthreads();
    { const int d4 = tid & 15, kh = (tid >> 4) & 3, jp = tid >> 6; f32x4 acc4[4];
#pragma unroll
      for (int hq = 0; hq < 4; ++hq) acc4[hq] = (f32x4){0.f, 0.f, 0.f, 0.f};
#pragma unroll 4
      for (int jj = 0; jj < 16; ++jj) { const int j = jp * 16 + jj; f32x4 vv;
          if (j < 127) vv = *(const f32x4*)(AIN(3) + (((size_t)s * 128 + j + 1) * 4 + kh) * 64 + 4 * d4); else vv = *(const LAS f32x4*)(vn + kh * 64 + 4 * d4);
#pragma unroll
          for (int hq = 0; hq < 4; ++hq) acc4[hq] += sc[(kh * 4 + hq) * 128 + j] * vv; }
#pragma unroll
      for (int hq = 0; hq < 4; ++hq) *(LAS f32x4*)(red + (jp * 16 + kh * 4 + hq) * 64 + 4 * d4) = acc4[hq]; }
    __syncthreads();
    { const int h = tid >> 5, d2 = tid & 31; float o0 = 0.f, o1 = 0.f;
#pragma unroll
      for (int jp = 0; jp < 8; ++jp) { o0 += red[(jp * 16 + h) * 64 + d2]; o1 += red[(jp * 16 + h) * 64 + 32 + d2]; }
      float ss = o0 * o0 + o1 * o1;
#pragma unroll
      for (int o = 1; o < 32; o <<= 1) ss += __shfl_xor(ss, o);
      MIX[(size_t)row * DM + 1024 + h * 64 + d2] = (bf16_t)f2bf(o0); MIX[(size_t)row * DM + 1024 + h * 64 + 32 + d2] = (bf16_t)f2bf(o1);
      if (d2 == 0) unsafeAtomicAdd(ssqA + row, ss); }
}


#define XB_TMO      128
#define XB_XCNT(j)  (256  + 64 * (j))
#define XB_XSUB(j)  (1280 + 64 * (j))
#define XB_XGEN(j)  (2304 + 64 * (j))
#define XB_TOP      3328
#define XB_TOPGEN   3392
#define XCD_BAR_WORDS 3456
#define XB_SPIN_CAP (1u << 22)
__device__ __forceinline__ unsigned xb_ld(unsigned* p)              { return __hip_atomic_load(p, __ATOMIC_RELAXED, __HIP_MEMORY_SCOPE_AGENT); }
__device__ __forceinline__ unsigned xb_add(unsigned* p, unsigned v) { return __hip_atomic_fetch_add(p, v, __ATOMIC_RELAXED, __HIP_MEMORY_SCOPE_AGENT); }
__device__ __forceinline__ unsigned xb_xcc_id() { return (unsigned)__builtin_amdgcn_s_getreg((3 << 11) | 20) & 0xFu; }
#define XB_SPIN(cond, bar) do { unsigned _sp = 0; while (cond) { __builtin_amdgcn_s_sleep(1); \
    if ((++_sp & 255u) == 0u) { if (xb_ld(&(bar)[XB_TMO])) break; if (_sp > XB_SPIN_CAP) { atomicAdd(&(bar)[XB_TMO], 1u); break; } } } } while (0)
struct XcdBarrier { unsigned* bar; unsigned x; volatile LAS unsigned* st; };
__device__ __forceinline__ XcdBarrier xcd_barrier_post(unsigned* bar, volatile LAS unsigned* st) {
    XcdBarrier b; b.bar = bar; b.x = xb_xcc_id(); b.st = st;
    if (threadIdx.x == 0) (void)xb_add(&bar[XB_XCNT(b.x)], 1u);
    return b;
}
__device__ __forceinline__ void xcd_barrier_complete(unsigned* bar, unsigned x, unsigned& nloc, unsigned& nx) {
    const unsigned G = gridDim.x * gridDim.y * gridDim.z;
    unsigned sum, cnt, mine, sp = 0u;
    for (;;) {
        sum = 0u; cnt = 0u; mine = 0u;
#pragma unroll
        for (unsigned j = 0; j < 16; ++j) { const unsigned c = xb_ld(&bar[XB_XCNT(j)]); sum += c; cnt += (c > 0u) ? 1u : 0u; mine = (j == x) ? c : mine; }
        if (sum == G) break;
        __builtin_amdgcn_s_sleep(1);
        if ((++sp & 255u) == 0u) { if (xb_ld(&bar[XB_TMO])) break; if (sp > XB_SPIN_CAP) { atomicAdd(&bar[XB_TMO], 1u); break; } }
    }
    nloc = mine > 0u ? mine : 1u; nx = cnt > 0u ? cnt : 1u;
}
__device__ __forceinline__ void xcd_barrier(const XcdBarrier& b) {
    asm volatile("s_waitcnt vmcnt(0)" ::: "memory");
    __syncthreads();
    if (threadIdx.x == 0) {
        unsigned* bar = b.bar;
        __builtin_amdgcn_s_waitcnt(0);
        unsigned nloc = b.st[0], nx = b.st[1];
        if (nloc == 0u) { xcd_barrier_complete(bar, b.x, nloc, nx); b.st[0] = nloc; b.st[1] = nx; }
        const unsigned old = xb_add(&bar[XB_XSUB(b.x)], 1u);
        const unsigned gen = old / nloc;
        if (old + 1u == (gen + 1u) * nloc) {
            __builtin_amdgcn_fence(__ATOMIC_RELEASE, "agent");
            asm volatile("s_waitcnt vmcnt(0)" ::: "memory");
            const unsigned og = xb_add(&bar[XB_TOP], 1u);
            const unsigned tg = og / nx;
            if (og + 1u == (tg + 1u) * nx) xb_add(&bar[XB_TOPGEN], 1u);
            else XB_SPIN(xb_ld(&bar[XB_TOPGEN]) == tg, bar);
            __builtin_amdgcn_fence(__ATOMIC_ACQUIRE, "agent");
            xb_add(&bar[XB_XGEN(b.x)], 1u);
            asm volatile("s_waitcnt vmcnt(0)" ::: "memory");
        } else {
            XB_SPIN(xb_ld(&bar[XB_XGEN(b.x)]) == gen, bar);
            __builtin_amdgcn_fence(__ATOMIC_ACQUIRE, "agent");
            asm volatile("s_waitcnt vmcnt(0)" ::: "memory");
        }
    }
    __syncthreads();
}

__global__ void __launch_bounds__(512, 2) hymba_fwd(Args ka) {
    extern __shared__ __attribute__((aligned(16))) unsigned char lds_raw[];
    LAS unsigned char* lds = (LAS unsigned char*)lds_raw;
    cg::grid_group grid = cg::this_grid();
    const int tid = threadIdx.x, lane = tid & 63, wave = __builtin_amdgcn_readfirstlane(tid >> 6);
    const int G = gridDim.x, bx = blockIdx.x;
    const int gw = bx * 8 + wave, NGW = G * 8;
    const PTab a = (PTab)(lds + 146432 + 128);
#pragma unroll
    for (int i = 0; i < 31; ++i) if (tid == i) a[i] = (unsigned long long)ka.in[i];
    if (tid == 31) a[31] = (unsigned long long)ka.out;
    if (tid == 32) a[32] = (unsigned long long)ka.ws;
    __syncthreads();
    unsigned char* ws = AWS;
    volatile LAS unsigned* bst = (volatile LAS unsigned*)(lds + 146432 + 64);
    if (tid < 2) bst[tid] = 0u;
    __syncthreads();
    const XcdBarrier xbar = xcd_barrier_post((unsigned*)(ws + WS_CTL), bst);
#define GSYNC() xcd_barrier(xbar)
    bf16_t* WinT = (bf16_t*)(ws + WS_WIN); bf16_t* WgluT = (bf16_t*)(ws + WS_WGLU); bf16_t* WoutT = (bf16_t*)(ws + WS_WOUT); bf16_t* WupT = (bf16_t*)(ws + WS_WUP); bf16_t* WdownT = (bf16_t*)(ws + WS_WDOWN);
    bf16_t* H = (bf16_t*)(ws + WS_H) + 2 * DM;
    bf16_t* Z = (bf16_t*)(ws + WS_Z); bf16_t* YG = (bf16_t*)(ws + WS_YG); bf16_t* MIX = (bf16_t*)(ws + WS_MIX); bf16_t* ACT = (bf16_t*)(ws + WS_ACT);
    float* XMID = (float*)(ws + WS_XMID); float* ssqS = (float*)(ws + WS_SSQS); float* ssqA = (float*)(ws + WS_SSQA);

#ifndef ONLY
#define ONLY -1
#endif
#define PHON(k) (ONLY < 0 || ONLY == (k))
#ifndef PROBE_PHASE
#define PROBE_PHASE -1
#endif
#define REP(k) for (int rep_ = 0; rep_ < ((PROBE_PHASE == (k)) ? 2 : 1); ++rep_)
    REP(0) if (PHON(0)) {
        LAS float* scr = (LAS float*)(lds + wave * 16384);
        constexpr int I_IN = (DM / 64) * (DIN / 32), I_GLU = (DSSM / 64) * (DSSM / 32), I_OUT = (DM / 64) * (DM / 32), I_UP = (DM / 64) * (DFF2 / 32), I_DN = (DFF / 64) * (DM / 32);
        constexpr int NITEMS = I_IN + I_GLU + I_OUT;
        for (int it = gw; it < I_IN; it += NGW) transpose_item(AIN(9), DM, DIN, WinT, 0, nullptr, nullptr, scr, it, lane);
        for (int m = gw; m < MROWS; m += NGW) rms_row_to_bf16(pg8::xrow_ptr(AIN(0), AIN(1), AIN(7), m), AIN(8), H + (size_t)m * DM, lane);
        f32x2* rope = (f32x2*)(ws + WS_ROPE);
        for (int e = bx * 512 + tid; e < NROPE * 32; e += G * 512) {
            const int pi = e >> 5, i = e & 31; const int pos = pi < TP ? pi : PASTLEN;
            double inv = 1.0; for (int k = 0; k < i; ++k) inv *= 0.74989420933245582730;
            const float ang = (float)pos * (float)inv; float sn, cs; sincos_rev((double)ang * 0.15915494309189533577, sn, cs);
            rope[e] = (f32x2){cs, sn};
        }
        for (int e = bx * 512 + tid; e < MROWS; e += G * 512) { ssqS[e] = 0.f; ssqA[e] = 0.f; }
    }
    grid.sync();
    if (PHON(1)) { typedef pg8::Order<MROWS / 256, DIN / 256, DM / 64, false> Ord; Ord S; S.init(G, bx); pg8::EpiZ E{a};
      pg8::gemm_phase<pg8::EpiZ, false, Ord>(lds, H, WinT, S, E);
      constexpr int NU = (MROWS / 256) * (DIN / 256); const int nrem = NU % G;
      if (nrem > 0 && bx >= nrem) { LAS float* scr = (LAS float*)(lds + wave * 16384); constexpr int I_UP = (DM / 64) * (DFF2 / 32);
          for (int it = (bx - nrem) * 8 + wave; it < I_UP; it += (G - nrem) * 8) transpose_item(AIN(27), DM, DFF2, WupT, 1, nullptr, nullptr, scr, it, lane); }
      else if (nrem == 0) { LAS float* scr = (LAS float*)(lds + wave * 16384); constexpr int I_UP = (DM / 64) * (DFF2 / 32);
          for (int it = gw; it < I_UP; it += NGW) transpose_item(AIN(27), DM, DFF2, WupT, 1, nullptr, nullptr, scr, it, lane); } }
    GSYNC();
    if (PHON(2)) {
        constexpr int NSSM = 128;
        if (bx < NSSM) {
            LAS unsigned char* pl = lds + (wave & 3) * PAIR_LDS;
            if (wave < 4 && lane < 2) ((volatile LAS unsigned*)(pl + PAIR_FLG))[lane] = 0u;
            __syncthreads();
#ifndef NO_SSM
            const int un = bx * 4 + (wave & 3);
            if (wave < 4) { ssm_wave(a, pl, true, un >> 6, un & 63, lane);
                            ssm_scan_role(a, pl, un >> 6, un & 63, lane); }
            else ssm_out_role(a, pl, un >> 6, un & 63, lane);
#endif
        } else {
            const int nA = NB * 4 * 33, nTot = nA + NS;
#pragma unroll 1
            for (int it = bx - NSSM; it < nTot; it += G - NSSM) {
                if (it < nA) {
#ifndef NO_AP
                    const int b = it / 132, r = it - b * 132; attn_prompt_unit(a, lds, b, r / 33, r % 33, tid);
#endif
                } else {
#ifndef NO_AS
                    attn_sample_unit(a, lds, it - nA, tid);
#endif
                }
            }
        }
            __syncthreads();
            { LAS float* scr = (LAS float*)(lds + wave * 16384);
              const int cw = bx * 8 + wave, NCW = G * 8;
              constexpr int I_GLU = (DSSM / 64) * (DSSM / 32), I_OUT = (DM / 64) * (DM / 32), I_DN = (DFF / 64) * (DM / 32);
              for (int it = cw; it < I_GLU + I_OUT + I_DN; it += NCW) {
                  if (it < I_GLU) transpose_item(AIN(21), DSSM, DSSM, WgluT, 0, nullptr, nullptr, scr, it, lane);
                  else if (it < I_GLU + I_OUT) transpose_item(AIN(25), DM, DM, WoutT, 0, AIN(23), AIN(24), scr, it - I_GLU, lane);
                  else transpose_item(AIN(30), DFF, DM, WdownT, 0, nullptr, nullptr, scr, it - I_GLU - I_OUT, lane); }
              for (int e = cw * 64 + lane; e < NS * 127 * 64; e += NCW * 64) { const int s = e / (127 * 64), rj = e - s * (127 * 64), j = rj >> 6, c4 = rj & 63;
                  const size_t so = ((size_t)s * 128 + j + 1) * 256 + 4 * c4, dd = ((size_t)s * 128 + j) * 256 + 4 * c4;
                  *(f32x4*)(AOUT + O_SK + dd) = *(const f32x4*)(AIN(2) + so); *(f32x4*)(AOUT + O_SV + dd) = *(const f32x4*)(AIN(3) + so); } }
    }
    GSYNC();
    if (PHON(3)) { typedef pg8::Order<MROWS / 256, DSSM / 256, DSSM / 64, true> Ord; Ord S; S.init(G, bx); pg8::EpiGlu E{a, S.nsplit()};
      pg8::gemm_phase<pg8::EpiGlu, false, Ord>(lds, YG, WgluT, S, E);
      { pg8::Unit pu; if (S.piece(pu)) E.finish(pu); } }
    GSYNC();
    if (PHON(4)) { typedef pg8::Order<MROWS / 256, DM / 256, DM / 64, true> Ord; Ord S; S.init(G, bx); pg8::EpiOut E{a, S.nsplit(), ws};
      pg8::gemm_phase<pg8::EpiOut, false, Ord>(lds, MIX, WoutT, S, E);
      { pg8::Unit pu; if (S.piece(pu)) E.finish(pu); } }
    GSYNC();
    if (PHON(5)) for (int m = gw; m < MROWS; m += NGW) rms_row_to_bf16(XMID + (size_t)m * DM, AIN(26), H + (size_t)m * DM, lane);
    GSYNC();
    if (PHON(6)) { typedef pg8::Order<68, DFF2 / 256, DM / 64, false> Ord; Ord S; S.init(G, bx); pg8::EpiUp E{a};
      pg8::gemm_phase<pg8::EpiUp, true, Ord>(lds, H - 2 * DM, WupT, S, E); }
    GSYNC();
    if (PHON(7)) { typedef pg8::Order<MROWS / 256, DM / 256, DFF / 64, true> Ord; Ord S; S.init(G, bx); pg8::EpiDown E{a, S.nsplit()};
      pg8::gemm_phase<pg8::EpiDown, false, Ord>(lds, ACT, WdownT, S, E);
      { pg8::Unit pu; if (S.piece(pu)) E.finish(pu); } }
}

extern "C" void kernel_launch(void* const* d_in, const int* in_sizes, int n_in, void* d_out, int out_size, void* d_ws, size_t ws_size, hipStream_t stream) {
    static int grid = 0;
    if (grid == 0) {
        if (n_in != 31 || (size_t)out_size != O_END || ws_size < WS_END) { fprintf(stderr, "kernel_launch: unexpected shapes: n_in %d out %d (want %zu) ws %zu (want %zu)\n", n_in, out_size, (size_t)O_END, ws_size, (size_t)WS_END); grid = -1; return; }
        int dev = 0, cus = 0, per_cu = 0;
        (void)hipGetDevice(&dev); (void)hipDeviceGetAttribute(&cus, hipDeviceAttributeMultiprocessorCount, dev);
        if (hipFuncSetAttribute((const void*)hymba_fwd, hipFuncAttributeMaxDynamicSharedMemorySize, LDS_BYTES) != hipSuccess) { fprintf(stderr, "kernel_launch: hipFuncSetAttribute failed\n"); grid = -1; return; }
        (void)hipOccupancyMaxActiveBlocksPerMultiprocessor(&per_cu, (const void*)hymba_fwd, 512, LDS_BYTES);
        if (per_cu < 1) { fprintf(stderr, "kernel_launch: occupancy query says %d blocks per CU\n", per_cu); per_cu = 1; }
        (void)hipGetLastError();
        grid = cus;
    }
    if (grid < 0) return;
    if (hipMemsetAsync((char*)d_ws + WS_CTL, 0, CTL_BYTES, stream) != hipSuccess) { fprintf(stderr, "kernel_launch: memset failed\n"); return; }
    Args a{};
    for (int i = 0; i < 31; ++i) a.in[i] = (const float*)d_in[i];
    a.out = (float*)d_out; a.ws = (unsigned char*)d_ws;
    void* args[] = {&a};
    hipError_t e = hipLaunchCooperativeKernel((const void*)hymba_fwd, dim3(grid), dim3(512), args, LDS_BYTES, stream);
    if (e != hipSuccess) fprintf(stderr, "kernel_launch: cooperative launch failed: %s (grid %d)\n", hipGetErrorString(e), grid);
}
```

```cpp
#include <hip/hip_runtime.h>
#include <hip/hip_cooperative_groups.h>
#include <cstdio>
#include <cstdint>
namespace cg = cooperative_groups;

#define LAS __attribute__((address_space(3)))
typedef unsigned short bf16_t;
typedef short bf16x8 __attribute__((ext_vector_type(8)));
typedef float f32x4 __attribute__((ext_vector_type(4)));
typedef float f32x2 __attribute__((ext_vector_type(2)));
typedef float f32x16 __attribute__((ext_vector_type(16)));
typedef unsigned u32x4 __attribute__((ext_vector_type(4)));
typedef unsigned u32x2 __attribute__((ext_vector_type(2)));

constexpr int DM = 2048, NB = 8, SEQ = 2048, NMETA = 16, TP = SEQ + NMETA, NPR = NB * TP, NS = 128, MROWS = NPR + NS;
constexpr int DSSM = 1024, DATT = 1024, DKV = 256, DIN = 2560, DFF = 5632, DFF2 = 11264, ZP = DIN;
constexpr int PASTLEN = 16384, NROPE = TP + 1;
constexpr float EPS = 1e-6f;
static_assert(MROWS % 256 == 0, "rows");

constexpr size_t WS_WIN = 0;
constexpr size_t WS_WGLU = WS_WIN + (size_t)DIN * DM * 2;
constexpr size_t WS_WOUT = WS_WGLU + (size_t)DSSM * DSSM * 2;
constexpr size_t WS_WUP = WS_WOUT + (size_t)DM * DM * 2;
constexpr size_t WS_WDOWN = WS_WUP + (size_t)DFF2 * DM * 2;
constexpr size_t WS_ROPE = WS_WDOWN + (size_t)DM * DFF * 2;
constexpr size_t WS_CTL = WS_ROPE + 786432, CTL_BYTES = 32768;
constexpr size_t WS_SSQS = WS_ROPE + (1u << 20);
constexpr size_t WS_SSQA = WS_SSQS + (size_t)MROWS * 16 * 4;
constexpr size_t WS_H = WS_SSQA + (size_t)MROWS * 16 * 4;
constexpr size_t H_ROWS = 17000;
constexpr size_t WS_Z = WS_H + H_ROWS * DM * 2;
constexpr size_t WS_YG = WS_Z + (size_t)MROWS * ZP * 2;
constexpr size_t WS_MIX = WS_YG + (size_t)MROWS * DSSM * 2;
constexpr size_t WS_ACT = WS_Z;
constexpr size_t WS_XMID = WS_MIX + (size_t)MROWS * DM * 2;
constexpr size_t WS_END = WS_XMID + (size_t)MROWS * DM * 4;
static_assert(WS_ACT + (size_t)MROWS * DFF * 2 <= WS_XMID, "ACT overlay");
static_assert(WS_WGLU % 256 == 0 && WS_WOUT % 256 == 0 && WS_WUP % 256 == 0 && WS_WDOWN % 256 == 0 && WS_ROPE % 256 == 0 && WS_H % 256 == 0 && WS_Z % 256 == 0 && WS_XMID % 256 == 0, "align");

constexpr size_t O_YP = 0, O_YS = O_YP + (size_t)NB * SEQ * DM, O_PK = O_YS + (size_t)NS * DM, O_PV = O_PK + (size_t)NB * 128 * 256,
                 O_PRE = O_PV + (size_t)NB * 128 * 256, O_PIM = O_PRE + (size_t)NB * 64 * 64, O_PCONV = O_PIM + (size_t)NB * 64 * 64,
                 O_SK = O_PCONV + (size_t)NB * 2 * DFF2, O_SV = O_SK + (size_t)NS * 128 * 256, O_SRE = O_SV + (size_t)NS * 128 * 256,
                 O_SIM = O_SRE + (size_t)NS * 64 * 64, O_SCONV = O_SIM + (size_t)NS * 64 * 64, O_END = O_SCONV + (size_t)NS * 2 * DFF2;

constexpr int LDS_BYTES = 147456;

struct Args {
    const float* in[31];
    float* out;
    unsigned char* ws;
};

__device__ __forceinline__ unsigned f2bf(float f) { unsigned u = __builtin_bit_cast(unsigned, f); return (u + 0x7fffu + ((u >> 16) & 1u)) >> 16; }
typedef __bf16 bf16x2_t __attribute__((ext_vector_type(2)));
__device__ __forceinline__ unsigned pk2(float lo, float hi) { const f32x2 v = {lo, hi}; return __builtin_bit_cast(unsigned, __builtin_convertvector(v, bf16x2_t)); }
__device__ __forceinline__ float bf2f(unsigned short b) { return __builtin_bit_cast(float, (unsigned)b << 16); }
__device__ __forceinline__ float bflo(unsigned w) { return __builtin_bit_cast(float, w << 16); }
__device__ __forceinline__ float bfhi(unsigned w) { return __builtin_bit_cast(float, w & 0xffff0000u); }
__device__ __forceinline__ float wave_sum(float v) {
#pragma unroll
    for (int o = 1; o < 64; o <<= 1) v += __shfl_xor(v, o);
    return v;
}
__device__ __forceinline__ float wave_max(float v) {
#pragma unroll
    for (int o = 1; o < 64; o <<= 1) v = fmaxf(v, __shfl_xor(v, o));
    return v;
}
__device__ __forceinline__ void sincos_rev(double rev, float& s, float& c) {
    double r = rev - __builtin_floor(rev);
    double q = __builtin_floor(r * 4.0 + 0.5);
    double x = (r - q * 0.25) * 6.283185307179586476925;
    double x2 = x * x;
    double sp = x * (1.0 + x2 * (-1.0 / 6 + x2 * (1.0 / 120 + x2 * (-1.0 / 5040 + x2 * (1.0 / 362880 + x2 * (-1.0 / 39916800 + x2 * (1.0 / 6227020800.0)))))));
    double cp = 1.0 + x2 * (-0.5 + x2 * (1.0 / 24 + x2 * (-1.0 / 720 + x2 * (1.0 / 40320 + x2 * (-1.0 / 3628800 + x2 * (1.0 / 479001600 + x2 * (-1.0 / 87178291200.0)))))));
    int qi = ((int)q) & 3;
    double ss = (qi == 0) ? sp : (qi == 1) ? cp : (qi == 2) ? -sp : -cp;
    double cc = (qi == 0) ? cp : (qi == 1) ? -sp : (qi == 2) ? -cp : sp;
    s = (float)ss; c = (float)cc;
}
__device__ __forceinline__ float gelu_tanh(float y) {
    float z = 0.7978845608028654f * (y + 0.044715f * y * y * y);
    float e = __expf(2.0f * z);
    float th = 1.0f - 2.0f * __builtin_amdgcn_rcpf(e + 1.0f);
    return 0.5f * y * (1.0f + th);
}
__device__ __forceinline__ float sigmoidf_(float v) { return __builtin_amdgcn_rcpf(1.0f + __expf(-v)); }


typedef LAS unsigned long long* PTab;
__device__ __forceinline__ unsigned long long rfl64(unsigned long long v) { const unsigned lo = __builtin_amdgcn_readfirstlane((unsigned)v), hi = __builtin_amdgcn_readfirstlane((unsigned)(v >> 32)); return ((unsigned long long)hi << 32) | lo; }
#define GAS __attribute__((address_space(1)))
#define AIN(i) ((const float*)(const GAS float*)rfl64(a[(i)]))
#define AOUT ((float*)(GAS float*)rfl64(a[31]))
#define AWS ((unsigned char*)(GAS unsigned char*)rfl64(a[32]))

namespace pg8 {
constexpr int BM = 256, BK = 64, HALF = 128, HTB = HALF * BK * 2, STAGE_BYTES = 8 * HTB, NXCD = 8, WGM = 8;
__device__ __forceinline__ int lds_byte(int r, int c) { const int st = (r >> 4) * 2 + (c >> 5), rr = r & 15, cc = c & 31, ob = rr * 64 + cc * 2; return st * 1024 + (ob ^ (((ob >> 9) & 1) << 5)); }
__device__ __forceinline__ void stage_rc(int b, int& R, int& C) { const int st = b / 1024, sb = b % 1024, swz = sb ^ (((sb >> 9) & 1) << 5); R = (st >> 1) * 16 + swz / 64; C = (st & 1) * 32 + (swz % 64) / 2; }
__device__ __forceinline__ int perm32(int rho) { const int n = rho >> 4, i = rho & 15; return 8 * (i >> 2) + 4 * n + (i & 3); }

struct Unit { int pm, pn, k0, nk, sj, sc; };

template <int NM, int NN, int NT, bool SPLIT>
struct Order {
    static constexpr int nM = NM, nN = NN, nt = NT, nwg = NM * NN;
    int G, c;
    __device__ __forceinline__ void init(int G_, int c_) { G = G_; c = c_; }
    __device__ __forceinline__ int nfull() const { return SPLIT ? nwg - nwg % G : nwg; }
    __device__ __forceinline__ int cs() const { if (!SPLIT) return NT; const int R = nwg % G; if (R == 0) return NT; const int per = G / R; return 2 * (((NT / 2) + per - 1) / per); }
    __device__ __forceinline__ int nsplit() const { const int c_ = cs(); return (NT + c_ - 1) / c_; }
    __device__ __forceinline__ void map(int L, int& pm, int& pn) const {
        int wgid = L; { const int q = nwg / NXCD, r = nwg % NXCD, xcd = wgid % NXCD, off = wgid / NXCD; wgid = (xcd < r ? xcd * (q + 1) : r * (q + 1) + (xcd - r) * q) + off; }
        const int nig = WGM * nN, gid = wgid / nig, fm = gid * WGM, gsz = (nM - fm) < WGM ? (nM - fm) : WGM;
        pm = fm + ((wgid % nig) % gsz); pn = (wgid % nig) / gsz;
    }
    __device__ __forceinline__ int npieces() const { return SPLIT ? (nwg - nfull()) * nsplit() : 0; }
    __device__ __forceinline__ bool next(int i, Unit& u) const {
        const int nf = nfull(), np = npieces();
        const bool haspc = SPLIT && c < np;
        const bool ispc = haspc && i == 1;
        const int iw = (haspc && i >= 2) ? i - 1 : i;
        const int L = iw * G + c;
        const bool full = !ispc && L < nf;
        const int S = SPLIT ? nsplit() : 1, cs_ = SPLIT ? cs() : NT;
        const int p = c, sj = ispc ? p / S : 0, sc = ispc ? p - sj * S : 0;
        int pm, pn; map(ispc ? nf + sj : (full ? L : 0), pm, pn);
        const int k0 = ispc ? sc * cs_ : 0;
        const int nk = ispc ? ((NT - k0) < cs_ ? (NT - k0) : cs_) : NT;
        u = Unit{pm, pn, k0, nk, sj, sc};
        return ispc || full;
    }
    __device__ __forceinline__ bool piece(Unit& u) const { if (!(SPLIT && c < npieces())) return false; return next(1, u); }
};

__device__ __forceinline__ unsigned cvt_pk_bf16(float lo, float hi) { unsigned r; asm volatile("v_cvt_pk_bf16_f32 %0, %1, %2" : "=v"(r) : "v"(lo), "v"(hi)); return r; }

template <class Epi, bool ACHUNK, class Ord>
__device__ __forceinline__ void gemm_phase(LAS unsigned char* lds, const bf16_t* gA, const bf16_t* gBt, const Ord& S, const Epi& E) {
    int tid = threadIdx.x; asm volatile("" : "+v"(tid));
    const int wid = __builtin_amdgcn_readfirstlane(tid >> 6), lane = tid & 63, wr = wid >> 2, wc = wid & 3, fr = lane & 15, fq = lane >> 4;
    constexpr int K = Ord::nt * BK, ntot = Ord::nt;
    unsigned voffA[2], voffB[2];
#pragma unroll
    for (int i = 0; i < 2; ++i) { int R, C; stage_rc(tid * 16 + i * 8192, R, C); const int Rb = Epi::PERM ? ((R & ~31) + perm32(R & 31)) : R;
        const int Ra = ACHUNK ? (62 * (R >> 6) + (R & 63)) : R;
        voffA[i] = (unsigned)(Ra * K + C) * 2u; voffB[i] = (unsigned)(Rb * K + C) * 2u; }
    const size_t kstep = (size_t)(BK * 2);
    const size_t hsB = (size_t)HALF * K * 2, tsB = 2 * hsB;
    const size_t hsA = ACHUNK ? (size_t)124 * K * 2 : hsB, tsA = 2 * hsA;
    const unsigned ldsw = (unsigned)wid * 1024u;
    const int aoff = lds_byte(wr * 64 + fr, fq * 8), boff = lds_byte(wc * 32 + fr, fq * 8);
#define PG8_SA(b, h) (((b) * 2 + (h)) * HTB)
#define PG8_SB(b, h) ((4 + (b) * 2 + (h)) * HTB)
#define PG8_STAGE(bufoff, gbase, voff) do { _Pragma("unroll") for (int _i = 0; _i < 2; ++_i) \
        __builtin_amdgcn_global_load_lds((const unsigned*)((const char*)(gbase) + (voff)[_i]), (LAS unsigned*)(lds + (bufoff) + ldsw + _i * 8192), 16, 0, 0); } while (0)
#define PG8_LDA(dst, b, h) do { _Pragma("unroll") for (int m = 0; m < 4; ++m) _Pragma("unroll") for (int k = 0; k < 2; ++k) dst[m][k] = *(const LAS bf16x8*)(lds + PG8_SA(b, h) + aoff + m * 2048 + k * 1024); } while (0)
#define PG8_LDB(dst, b, h) do { _Pragma("unroll") for (int n = 0; n < 2; ++n) _Pragma("unroll") for (int k = 0; k < 2; ++k) dst[n][k] = *(const LAS bf16x8*)(lds + PG8_SB(b, h) + boff + n * 2048 + k * 1024); } while (0)
#define PG8_MMA(ai, bj, At, Bt) do { __builtin_amdgcn_s_setprio(1); _Pragma("unroll") for (int m = 0; m < 4; ++m) _Pragma("unroll") for (int n = 0; n < 2; ++n) _Pragma("unroll") for (int k = 0; k < 2; ++k) \
        acc[ai][bj][m][n] = __builtin_amdgcn_mfma_f32_16x16x32_bf16(Bt[n][k], At[m][k], acc[ai][bj][m][n], 0, 0, 0); __builtin_amdgcn_s_setprio(0); } while (0)
#define PG8_WAIT_V(n) asm volatile("s_waitcnt vmcnt(" #n ")" ::: "memory")
#define PG8_WAIT_L(n) asm volatile("s_waitcnt lgkmcnt(" #n ")" ::: "memory")
#define PG8_BAR __builtin_amdgcn_s_barrier()
#define PG8_SCHED __builtin_amdgcn_sched_barrier(0)
    Unit cur, nxt; int ui = 0;
    if (!S.next(0, cur)) return;
    f32x4 acc[2][2][4][2];
#pragma unroll
    for (int a = 0; a < 2; ++a)
#pragma unroll
        for (int b = 0; b < 2; ++b)
#pragma unroll
            for (int m = 0; m < 4; ++m)
#pragma unroll
                for (int n = 0; n < 2; ++n) acc[a][b][m][n] = (f32x4){0.f, 0.f, 0.f, 0.f};
    bf16x8 At[4][2], B0[2][2], B1[2][2];
    const char* cA = (const char*)gA + (size_t)cur.pm * tsA + (size_t)cur.k0 * kstep; const char* cB = (const char*)gBt + (size_t)cur.pn * tsB + (size_t)cur.k0 * kstep;
    PG8_STAGE(PG8_SB(0, 0), cB, voffB); PG8_STAGE(PG8_SB(0, 1), cB + hsB, voffB); PG8_STAGE(PG8_SA(0, 0), cA, voffA); PG8_STAGE(PG8_SA(0, 1), cA + hsA, voffA);
    if (wr == 1) PG8_BAR;
    PG8_WAIT_V(2); PG8_BAR;
    PG8_STAGE(PG8_SB(1, 0), cB + kstep, voffB); PG8_STAGE(PG8_SA(1, 0), cA + kstep, voffA); PG8_STAGE(PG8_SB(1, 1), cB + hsB + kstep, voffB);
    PG8_WAIT_V(6); PG8_BAR;
    for (;;) {
        const bool has_next = S.next(ui + 1, nxt);
        const char* nA = has_next ? (const char*)gA + (size_t)nxt.pm * tsA + (size_t)nxt.k0 * kstep : cA; const char* nB = has_next ? (const char*)gBt + (size_t)nxt.pn * tsB + (size_t)nxt.k0 * kstep : cB;
        const int nt = cur.nk;
        for (int t = 0; t < nt; t += 2) {
            const bool last = (t == nt - 2);
            const char* a1 = cA + (size_t)(t + 1) * kstep;
            const char* a2 = last ? nA : cA + (size_t)(t + 2) * kstep; const char* b2 = last ? nB : cB + (size_t)(t + 2) * kstep;
            const char* a3 = a2 + kstep; const char* b3 = b2 + kstep;
            if constexpr (Epi::MIDK) { if (t == ntot / 2 && nt == ntot) E.mid(acc, cur, wr, wc, fr, fq); }
            if constexpr (Epi::PRELOAD) { if (last) E.preload(cur, lds, tid); }
            PG8_LDB(B0, 0, 0); PG8_LDB(B1, 0, 1); PG8_SCHED; PG8_LDA(At, 0, 0); PG8_STAGE(PG8_SA(1, 1), a1 + hsA, voffA);
            PG8_WAIT_V(8); PG8_WAIT_L(0); PG8_BAR; PG8_MMA(0, 0, At, B0); PG8_MMA(0, 1, At, B1); PG8_BAR; PG8_SCHED;
            PG8_LDA(At, 0, 1); PG8_STAGE(PG8_SB(0, 0), b2, voffB); PG8_STAGE(PG8_SB(0, 1), b2 + hsB, voffB); PG8_STAGE(PG8_SA(0, 0), a2, voffA);
            PG8_WAIT_V(8); PG8_WAIT_L(0); PG8_BAR; PG8_MMA(1, 0, At, B0); PG8_MMA(1, 1, At, B1); PG8_BAR; PG8_SCHED;
            PG8_LDB(B0, 1, 0); PG8_LDB(B1, 1, 1); PG8_SCHED; PG8_LDA(At, 1, 0); PG8_STAGE(PG8_SA(0, 1), a2 + hsA, voffA);
            PG8_WAIT_V(8); PG8_WAIT_L(0); PG8_BAR; PG8_MMA(0, 0, At, B0); PG8_MMA(0, 1, At, B1); PG8_BAR; PG8_SCHED;
            PG8_LDA(At, 1, 1); PG8_STAGE(PG8_SB(1, 0), b3, voffB); PG8_STAGE(PG8_SB(1, 1), b3 + hsB, voffB); PG8_STAGE(PG8_SA(1, 0), a3, voffA);
            PG8_WAIT_V(8); PG8_WAIT_L(0); PG8_BAR; PG8_MMA(1, 0, At, B0); PG8_MMA(1, 1, At, B1); PG8_BAR; PG8_SCHED;
        }
        if (wr == 0) PG8_BAR;
        E(acc, cur, wr, wc, fr, fq);
        if (!has_next) break;
#pragma unroll
        for (int a = 0; a < 2; ++a)
#pragma unroll
            for (int b = 0; b < 2; ++b)
#pragma unroll
                for (int m = 0; m < 4; ++m)
#pragma unroll
                    for (int n = 0; n < 2; ++n) acc[a][b][m][n] = (f32x4){0.f, 0.f, 0.f, 0.f};
        cur = nxt; cA = nA; cB = nB; ++ui;
        if (wr == 1) PG8_BAR;
    }
    PG8_WAIT_V(0);
    PG8_BAR;
#undef PG8_SA
#undef PG8_SB
#undef PG8_STAGE
#undef PG8_LDA
#undef PG8_LDB
#undef PG8_MMA
#undef PG8_WAIT_V
#undef PG8_WAIT_L
#undef PG8_BAR
#undef PG8_SCHED
}


__device__ __forceinline__ void store_wt(float* p, f32x4 v) {
    asm volatile("global_store_dwordx4 %0, %1, off sc1\n\ts_nop 1" :: "v"(p), "v"(v) : "memory");
}
__device__ __forceinline__ void part_rc(int idx, int& trow, int& tcol) {
    const int lane = idx & 63, wv = (idx >> 6) & 7, slot = idx >> 9, n = slot & 1, bj = (slot >> 1) & 1, m = (slot >> 2) & 3, ai = slot >> 4;
    trow = ai * 128 + (wv >> 2) * 64 + m * 16 + (lane & 15); tcol = bj * 128 + (wv & 3) * 32 + n * 16 + 4 * (lane >> 4);
}
__device__ __forceinline__ void split_publish(unsigned* cnt) {
    asm volatile("s_waitcnt vmcnt(0)" ::: "memory");
    __syncthreads();
    if (threadIdx.x == 0) __hip_atomic_fetch_add(cnt, 1u, __ATOMIC_RELAXED, __HIP_MEMORY_SCOPE_AGENT);
}
__device__ __forceinline__ void split_wait(unsigned* cnt, unsigned S) {
    if (threadIdx.x == 0) {
        unsigned sp = 0;
        while (__hip_atomic_load(cnt, __ATOMIC_RELAXED, __HIP_MEMORY_SCOPE_AGENT) < S) { __builtin_amdgcn_s_sleep(2); if (++sp > (1u << 22)) break; }
        __builtin_amdgcn_fence(__ATOMIC_ACQUIRE, "agent");
        asm volatile("s_waitcnt vmcnt(0)" ::: "memory");
    }
    __syncthreads();
}
struct EpiZ {
    static constexpr bool PERM = true, MIDK = false, PRELOAD = false;
    PTab a;
    __device__ __forceinline__ void operator()(const f32x4 (&acc)[2][2][4][2], const Unit& u, int wr, int wc, int fr, int fq) const {
        bf16_t* O = (bf16_t*)(AWS + WS_Z); constexpr int ldc = ZP;
        const int row0 = u.pm * BM + wr * 64 + fr, col0 = u.pn * BM + wc * 32 + 8 * fq;
#pragma unroll
        for (int ai = 0; ai < 2; ++ai)
#pragma unroll
            for (int m = 0; m < 4; ++m) { bf16_t* rowp = O + (size_t)(row0 + ai * HALF + m * 16) * ldc + col0;
#pragma unroll
                for (int bj = 0; bj < 2; ++bj) { const f32x4 v0 = acc[ai][bj][m][0], v1 = acc[ai][bj][m][1];
                    u32x4 w; w.x = cvt_pk_bf16(v0[0], v0[1]); w.y = cvt_pk_bf16(v0[2], v0[3]); w.z = cvt_pk_bf16(v1[0], v1[1]); w.w = cvt_pk_bf16(v1[2], v1[3]);
                    *(u32x4*)(rowp + bj * HALF) = w; } }
    }
};
struct EpiGlu {
    static constexpr bool PERM = true, MIDK = false, PRELOAD = false;
    PTab a; int S;
    __device__ __forceinline__ void operator()(const f32x4 (&acc)[2][2][4][2], const Unit& u, int wr, int wc, int fr, int fq) const {
        unsigned char* ws_ = AWS; const bf16_t* YG = (const bf16_t*)(ws_ + WS_YG); bf16_t* MIX = (bf16_t*)(ws_ + WS_MIX); const float* bglu = AIN(22); float* ssq = (float*)(ws_ + WS_SSQS);
        const int row0 = u.pm * BM + wr * 64 + fr, col0 = u.pn * BM + wc * 32 + 8 * fq;
        if (u.nk == DSSM / 64) {
#pragma unroll
        for (int ai = 0; ai < 2; ++ai)
#pragma unroll
            for (int m = 0; m < 4; ++m) { const int row = row0 + ai * HALF + m * 16; float ss = 0.f;
#pragma unroll
                for (int bj = 0; bj < 2; ++bj) { const int col = col0 + bj * HALF;
                    const u32x4 yv = *(const u32x4*)(YG + (size_t)row * DSSM + col);
                    const f32x4 b0 = *(const f32x4*)(bglu + col), b1 = *(const f32x4*)(bglu + col + 4);
                    const f32x4 v0 = acc[ai][bj][m][0] + b0, v1 = acc[ai][bj][m][1] + b1;
                    float o[8];
                    o[0] = bflo(yv.x) * sigmoidf_(v0[0]); o[1] = bfhi(yv.x) * sigmoidf_(v0[1]); o[2] = bflo(yv.y) * sigmoidf_(v0[2]); o[3] = bfhi(yv.y) * sigmoidf_(v0[3]);
                    o[4] = bflo(yv.z) * sigmoidf_(v1[0]); o[5] = bfhi(yv.z) * sigmoidf_(v1[1]); o[6] = bflo(yv.w) * sigmoidf_(v1[2]); o[7] = bfhi(yv.w) * sigmoidf_(v1[3]);
#pragma unroll
                    for (int e = 0; e < 8; ++e) ss += o[e] * o[e];
                    u32x4 w; w.x = cvt_pk_bf16(o[0], o[1]); w.y = cvt_pk_bf16(o[2], o[3]); w.z = cvt_pk_bf16(o[4], o[5]); w.w = cvt_pk_bf16(o[6], o[7]);
                    *(u32x4*)(MIX + (size_t)row * DM + col) = w; }
                ss += __shfl_xor(ss, 16); ss += __shfl_xor(ss, 32);
                if (fq == 0) unsafeAtomicAdd(ssq + row, ss); }
        } else {
            float* pt = (float*)(ws_ + WS_H) + ((size_t)(u.sj * S + u.sc) << 16) + 4 * (fr + 16 * fq) + 256 * (wr * 4 + wc);
#pragma unroll
            for (int ai = 0; ai < 2; ++ai)
#pragma unroll
                for (int m = 0; m < 4; ++m)
#pragma unroll
                    for (int bj = 0; bj < 2; ++bj)
#pragma unroll
                        for (int n = 0; n < 2; ++n) { store_wt(pt, acc[ai][bj][m][n]); pt += 2048; asm volatile("" : "+v"(pt)); }
            split_publish((unsigned*)(ws_ + WS_CTL + 16384 + 4096) + 64 * u.sj);
        }
    }
    __device__ __forceinline__ void finish(const Unit& u) const {
        unsigned char* ws_ = AWS; const bf16_t* YG = (const bf16_t*)(ws_ + WS_YG); bf16_t* MIX = (bf16_t*)(ws_ + WS_MIX); const float* bglu = AIN(22); float* ssq = (float*)(ws_ + WS_SSQS);
        split_wait((unsigned*)(ws_ + WS_CTL + 16384 + 4096) + 64 * u.sj, (unsigned)S);
        const int lo = u.sc * 16384 / S, hi = (u.sc + 1) * 16384 / S; const float* pb = (const float*)(ws_ + WS_H) + ((size_t)(u.sj * S) << 16);
        for (int idx = lo + (int)threadIdx.x; idx < hi; idx += 512) { f32x4 sum = (f32x4){0.f, 0.f, 0.f, 0.f};
            for (int c0 = 0; c0 < S; c0 += 8) {
                f32x4 pv[8];
#pragma unroll
                for (int k = 0; k < 8; ++k) pv[k] = (c0 + k < S) ? *(const f32x4*)(pb + ((size_t)(c0 + k) << 16) + 4 * idx) : (f32x4){0.f, 0.f, 0.f, 0.f};
#pragma unroll
                for (int k = 0; k < 8; ++k) sum += pv[k]; }
            const int lane = idx & 63, wv = (idx >> 6) & 7, slot = idx >> 9, n = slot & 1, bj = (slot >> 1) & 1, m = (slot >> 2) & 3, ai = slot >> 4;
            const int row = u.pm * BM + ai * 128 + (wv >> 2) * 64 + m * 16 + (lane & 15), col = u.pn * BM + bj * 128 + (wv & 3) * 32 + 8 * (lane >> 4) + 4 * n;
            const u32x2 yv = *(const u32x2*)(YG + (size_t)row * DSSM + col); const f32x4 bb = *(const f32x4*)(bglu + col); const f32x4 v = sum + bb;
            const float o0 = bflo(yv.x) * sigmoidf_(v[0]), o1 = bfhi(yv.x) * sigmoidf_(v[1]), o2 = bflo(yv.y) * sigmoidf_(v[2]), o3 = bfhi(yv.y) * sigmoidf_(v[3]);
            u32x2 w; w.x = pk2(o0, o1); w.y = pk2(o2, o3); *(u32x2*)(MIX + (size_t)row * DM + col) = w;
            unsafeAtomicAdd(ssq + row, (o0 * o0 + o1 * o1) + (o2 * o2 + o3 * o3)); }
    }
};
__device__ __forceinline__ float row_rs(const float* ssq, int row) { return 1.0f / sqrtf(ssq[row] * (1.0f / 1024.0f) + EPS); }
__device__ __forceinline__ const float* xrow_ptr(const float* xp, const float* xs, const float* meta, int row) {
    if (row >= NPR) return xs + (size_t)(row - NPR) * DM;
    const int b = row / TP, t = row - b * TP;
    return t < NMETA ? meta + (size_t)t * DM : xp + ((size_t)b * SEQ + (t - NMETA)) * DM;
}
struct EpiOut {
    static constexpr bool PERM = false, MIDK = true, PRELOAD = false;
    PTab a; int S; unsigned char* wsp;
    __device__ __forceinline__ void mid(f32x4 (&acc)[2][2][4][2], const Unit& u, int wr, int wc, int fr, int fq) const {
        unsigned char* ws_ = wsp; const float* ssqS = (const float*)(ws_ + WS_SSQS); const float* ssqA = (const float*)(ws_ + WS_SSQA);
        int rowb = u.pm * BM + wr * 64 + fr; asm volatile("" : "+v"(rowb));
#pragma unroll
        for (int ai = 0; ai < 2; ++ai)
#pragma unroll
            for (int m = 0; m < 4; ++m) { const int row = rowb + ai * HALF + m * 16; float ratio = row_rs(ssqS, row) / row_rs(ssqA, row);
                asm volatile("" : "+v"(ratio) :: "memory");
#pragma unroll
                for (int bj = 0; bj < 2; ++bj)
#pragma unroll
                    for (int n = 0; n < 2; ++n) acc[ai][bj][m][n] *= ratio;
                asm volatile("" : "+v"(acc[ai][0][m][0]), "+v"(acc[ai][0][m][1]), "+v"(acc[ai][1][m][0]), "+v"(acc[ai][1][m][1]) :: "memory"); }
    }
    __device__ __forceinline__ void operator()(const f32x4 (&acc)[2][2][4][2], const Unit& u, int wr, int wc, int fr, int fq) const {
        unsigned char* ws_ = AWS; const float* ssqS = (const float*)(ws_ + WS_SSQS); const float* ssqA = (const float*)(ws_ + WS_SSQA); float* xmid = (float*)(ws_ + WS_XMID);
        float* part = (float*)(ws_ + WS_H); unsigned* cnt = (unsigned*)(ws_ + WS_CTL + 16384); const float *xp = AIN(0), *xs = AIN(1), *meta = AIN(7);
        const int tcol0 = wc * 32 + 4 * fq;
        const bool whole = u.nk == DM / 64;
        if (whole) {
#pragma unroll
            for (int ai = 0; ai < 2; ++ai)
#pragma unroll
                for (int m = 0; m < 4; ++m) { const int trow = ai * HALF + wr * 64 + m * 16 + fr, row = u.pm * BM + trow;
                    const float rsa = row_rs(ssqA, row);
                    const float* src = xrow_ptr(xp, xs, meta, row) + u.pn * BM; float* dst = xmid + (size_t)row * DM + u.pn * BM;
#pragma unroll
                    for (int bj = 0; bj < 2; ++bj)
#pragma unroll
                        for (int n = 0; n < 2; ++n) { const int tcol = tcol0 + bj * HALF + n * 16; const f32x4 xr = *(const f32x4*)(src + tcol); *(f32x4*)(dst + tcol) = xr + rsa * acc[ai][bj][m][n]; } }
        } else {
            float* pt = part + ((size_t)(u.sj * S + u.sc) << 16) + 4 * (fr + 16 * fq) + 256 * (wr * 4 + wc);
            const float* ssq = u.k0 >= DM / 128 ? ssqA : ssqS;
#pragma unroll
            for (int ai = 0; ai < 2; ++ai)
#pragma unroll
                for (int m = 0; m < 4; ++m) { const int row = u.pm * BM + ai * HALF + wr * 64 + m * 16 + fr; const float rsa = row_rs(ssq, row);
#pragma unroll
                    for (int bj = 0; bj < 2; ++bj)
#pragma unroll
                        for (int n = 0; n < 2; ++n) { const f32x4 v = rsa * acc[ai][bj][m][n]; store_wt(pt, v); pt += 2048; asm volatile("" : "+v"(pt)); } }
        }
        if (!whole) split_publish(cnt + 64 * u.sj);
    }
    __device__ __forceinline__ void finish(const Unit& u) const {
        unsigned char* ws_ = AWS; float* xmid = (float*)(ws_ + WS_XMID); float* part = (float*)(ws_ + WS_H); unsigned* cnt = (unsigned*)(ws_ + WS_CTL + 16384); const float *xp = AIN(0), *xs = AIN(1), *meta = AIN(7);
        split_wait(cnt + 64 * u.sj, (unsigned)S);
        const int lo = u.sc * 16384 / S, hi = (u.sc + 1) * 16384 / S; const float* pb = part + ((size_t)(u.sj * S) << 16);
        for (int idx = lo + (int)threadIdx.x; idx < hi; idx += 512) { f32x4 sum = (f32x4){0.f, 0.f, 0.f, 0.f};
            for (int c0 = 0; c0 < S; c0 += 12) {
                f32x4 pv[12];
#pragma unroll
                for (int k = 0; k < 12; ++k) pv[k] = (c0 + k < S) ? *(const f32x4*)(pb + ((size_t)(c0 + k) << 16) + 4 * idx) : (f32x4){0.f, 0.f, 0.f, 0.f};
#pragma unroll
                for (int k = 0; k < 12; ++k) sum += pv[k]; }
            int trow, tcol; part_rc(idx, trow, tcol); const int row = u.pm * BM + trow, col = u.pn * BM + tcol;
            *(f32x4*)(xmid + (size_t)row * DM + col) = sum + *(const f32x4*)(xrow_ptr(xp, xs, meta, row) + col); }
    }
};
struct EpiDown {
    static constexpr bool PERM = false, MIDK = false, PRELOAD = false;
    PTab a; int S;
    __device__ __forceinline__ float* dst_row(float* out, int row) const {
        if (row >= NPR) return out + O_YS + (size_t)(row - NPR) * DM;
        const int b = row / TP, t = row - b * TP; return t < NMETA ? nullptr : out + O_YP + ((size_t)b * SEQ + (t - NMETA)) * DM;
    }
    __device__ __forceinline__ void operator()(const f32x4 (&acc)[2][2][4][2], const Unit& u, int wr, int wc, int fr, int fq) const {
        unsigned char* ws_ = AWS; const float* xmid = (const float*)(ws_ + WS_XMID); float* out = AOUT; float* part = (float*)(ws_ + WS_H); unsigned* cnt = (unsigned*)(ws_ + WS_CTL + 16384 + 8192);
        const int tcol0 = wc * 32 + 4 * fq;
        const bool whole = u.nk == DFF / 64;
        if (whole) {
#pragma unroll
            for (int ai = 0; ai < 2; ++ai)
#pragma unroll
                for (int m = 0; m < 4; ++m) { const int trow = ai * HALF + wr * 64 + m * 16 + fr, row = u.pm * BM + trow;
                    float* dst = dst_row(out, row);
                    if (!dst) continue;
                    const float* src = xmid + (size_t)row * DM + u.pn * BM;
#pragma unroll
                    for (int bj = 0; bj < 2; ++bj)
#pragma unroll
                        for (int n = 0; n < 2; ++n) { const int tcol = tcol0 + bj * HALF + n * 16; const f32x4 xr = *(const f32x4*)(src + tcol); *(f32x4*)(dst + u.pn * BM + tcol) = xr + acc[ai][bj][m][n]; } }
        } else {
            float* pt = part + ((size_t)(u.sj * S + u.sc) << 16) + 4 * (fr + 16 * fq) + 256 * (wr * 4 + wc);
#pragma unroll
            for (int ai = 0; ai < 2; ++ai)
#pragma unroll
                for (int m = 0; m < 4; ++m)
#pragma unroll
                    for (int bj = 0; bj < 2; ++bj)
#pragma unroll
                        for (int n = 0; n < 2; ++n) { store_wt(pt, acc[ai][bj][m][n]); pt += 2048; asm volatile("" : "+v"(pt)); }
        }
        if (!whole) split_publish(cnt + 64 * u.sj);
    }
    __device__ __forceinline__ void finish(const Unit& u) const {
        unsigned char* ws_ = AWS; const float* xmid = (const float*)(ws_ + WS_XMID); float* out = AOUT; float* part = (float*)(ws_ + WS_H); unsigned* cnt = (unsigned*)(ws_ + WS_CTL + 16384 + 8192);
        split_wait(cnt + 64 * u.sj, (unsigned)S);
        const int lo = u.sc * 16384 / S, hi = (u.sc + 1) * 16384 / S; const float* pb = part + ((size_t)(u.sj * S) << 16);
        for (int idx = lo + (int)threadIdx.x; idx < hi; idx += 512) { f32x4 sum = (f32x4){0.f, 0.f, 0.f, 0.f};
            for (int c0 = 0; c0 < S; c0 += 12) {
                f32x4 pv[12];
#pragma unroll
                for (int k = 0; k < 12; ++k) pv[k] = (c0 + k < S) ? *(const f32x4*)(pb + ((size_t)(c0 + k) << 16) + 4 * idx) : (f32x4){0.f, 0.f, 0.f, 0.f};
#pragma unroll
                for (int k = 0; k < 12; ++k) sum += pv[k]; }
            int trow, tcol; part_rc(idx, trow, tcol); const int row = u.pm * BM + trow, col = u.pn * BM + tcol;
            float* dst = dst_row(out, row);
            if (dst) *(f32x4*)(dst + col) = sum + *(const f32x4*)(xmid + (size_t)row * DM + col); }
    }
};
#define DPP_ROR1 0x121
#define DPP_ROR2 0x122
#define DPP_SHR1 0x111
#define DPP_SHR2 0x112
__device__ __forceinline__ float dppf(float old, float src, const int ctrl_sel) {
    const int o = __builtin_bit_cast(int, old), s = __builtin_bit_cast(int, src); int r;
    if (ctrl_sel == 0) r = __builtin_amdgcn_update_dpp(o, s, DPP_ROR1, 0xf, 0xf, true);
    else if (ctrl_sel == 1) r = __builtin_amdgcn_update_dpp(o, s, DPP_ROR2, 0xf, 0xf, true);
    else if (ctrl_sel == 2) r = __builtin_amdgcn_update_dpp(o, s, DPP_SHR1, 0xf, 0xf, false);
    else r = __builtin_amdgcn_update_dpp(o, s, DPP_SHR2, 0xf, 0xf, false);
    return __builtin_bit_cast(float, r);
}
struct EpiUp {
    static constexpr bool PERM = true, MIDK = false, PRELOAD = true;
    PTab a; LAS unsigned char* ldsb;
    __device__ __forceinline__ void preload(const Unit& u, LAS unsigned char* lds, int tid) const {
        if (tid < 256) { const int p = tid >> 5, c = tid & 31; const float* src = (p & 3) < 3 ? AIN(28) + (size_t)(p & 3) * DFF2 : AIN(29); src += (p >> 2) * DFF + u.pn * 128 + 4 * c;
            __builtin_amdgcn_global_load_lds((const unsigned*)src, (LAS unsigned*)(lds + 131072 + (tid >> 6) * 1024), 16, 0, 0); }
    }
    __device__ __forceinline__ void operator()(const f32x4 (&acc)[2][2][4][2], const Unit& u, int wr, int wc, int fr, int fq) const {
        const float* stconv = AIN(6); bf16_t* ACT = (bf16_t*)(AWS + WS_ACT); float* out = AOUT;
        const LAS f32x4* tb = (const LAS f32x4*)(ldsb + 131072);
        const int colv0 = u.pn * 128 + wc * 32 + 8 * fq;
        int tt[2][4];
#pragma unroll
        for (int ai = 0; ai < 2; ++ai)
#pragma unroll
            for (int m = 0; m < 4; ++m) { const int row = u.pm * 248 + 62 * (2 * ai + wr) - 2 + 16 * m + fr;
                tt[ai][m] = ((m == 0 && fr < 2) || row >= MROWS) ? -1 : (row >= NPR ? (1 << 20) + (row - NPR) : row % TP); }
#pragma unroll
        for (int n = 0; n < 2; ++n) {
            const int cv = colv0 + 4 * n, cg_ = DFF + cv;
            const int ci = wc * 8 + 2 * fq + n;
            const f32x4 w0v = tb[ci], w1v = tb[32 + ci], w2v = tb[64 + ci], bv = tb[96 + ci];
            const f32x4 w0g = tb[128 + ci], w1g = tb[160 + ci], w2g = tb[192 + ci], bg = tb[224 + ci];
#pragma unroll
            for (int ai = 0; ai < 2; ++ai) {
                const int rbase = u.pm * 248 + 62 * (2 * ai + wr) - 2;
                f32x4 pvv = (f32x4){0.f, 0.f, 0.f, 0.f}, pvg = pvv;
#pragma unroll
                for (int m = 0; m < 4; ++m) {
                    const f32x4 cvv = acc[ai][0][m][n], cvg = acc[ai][1][m][n];
                    f32x4 p1v, p2v, p1g, p2g;
#pragma unroll
                    for (int e = 0; e < 4; ++e) {
                        p1v[e] = dppf(0.f, fr == 15 ? pvv[e] : cvv[e], 0); p2v[e] = dppf(0.f, fr >= 14 ? pvv[e] : cvv[e], 1);
                        p1g[e] = dppf(0.f, fr == 15 ? pvg[e] : cvg[e], 0); p2g[e] = dppf(0.f, fr >= 14 ? pvg[e] : cvg[e], 1);
                    }
                    pvv = cvv; pvg = cvg;
                    const int t = tt[ai][m];
                    if (t >= 0) {
                        const int row = rbase + 16 * m + fr;
                        if (t <= 1 || t >= TP - 2) {
                            if (t >= (1 << 20)) {
                                const int s = t - (1 << 20); const float* sc = stconv + (size_t)s * 2 * DFF2;
                                p2v = *(const f32x4*)(sc + cv); p1v = *(const f32x4*)(sc + DFF2 + cv); p2g = *(const f32x4*)(sc + cg_); p1g = *(const f32x4*)(sc + DFF2 + cg_);
                                float* so = out + O_SCONV + (size_t)s * 2 * DFF2;
                                *(f32x4*)(so + cv) = p1v; *(f32x4*)(so + cg_) = p1g; *(f32x4*)(so + DFF2 + cv) = cvv; *(f32x4*)(so + DFF2 + cg_) = cvg;
                            } else {
                                if (t == 0) { p1v = (f32x4){0.f, 0.f, 0.f, 0.f}; p1g = p1v; }
                                if (t <= 1) { p2v = (f32x4){0.f, 0.f, 0.f, 0.f}; p2g = p2v; }
                                if (t >= TP - 2) { const int b = row / TP; float* po = out + O_PCONV + ((size_t)b * 2 + (t - (TP - 2))) * DFF2; *(f32x4*)(po + cv) = cvv; *(f32x4*)(po + cg_) = cvg; }
                            }
                        }
                        const f32x4 cval = bv + w0v * p2v + w1v * p1v + w2v * cvv;
                        const f32x4 cgt = bg + w0g * p2g + w1g * p1g + w2g * cvg;
                        float o[4];
#pragma unroll
                        for (int e = 0; e < 4; ++e) o[e] = cgt[e] * sigmoidf_(cgt[e]) * cval[e];
                        u32x2 w; w.x = pk2(o[0], o[1]); w.y = pk2(o[2], o[3]);
                        *(u32x2*)(ACT + (size_t)row * DFF + cv) = w;
                    }
                }
            }
        }
    }
};
}

__device__ __forceinline__ void transpose_item(const float* W, int K, int N, bf16_t* WT, int mode, const float* ks0, const float* ks1, LAS float* scr, int item, int lane) {
    const int nblk = N / 32, kb = item / nblk, nb = item % nblk, k0 = 64 * kb, n0 = 32 * nb;
#pragma unroll 8
    for (int i = 0; i < 32; ++i) { const int kk = 2 * i + (lane >> 5); scr[kk * 33 + (lane & 31)] = W[(size_t)(k0 + kk) * N + n0 + (lane & 31)]; }
    asm volatile("s_waitcnt lgkmcnt(0)" ::: "memory");
    const int c = lane & 7;
    f32x4 ga = (f32x4){1.f, 1.f, 1.f, 1.f}, gb = ga;
    if (ks0) { const int k = k0 + 8 * c; const float* gp = k < 1024 ? ks0 + k : ks1 + (k - 1024); ga = *(const f32x4*)gp; gb = *(const f32x4*)(gp + 4); }
#pragma unroll
    for (int j = 0; j < 4; ++j) { const int n = (lane >> 3) + 8 * j; const LAS float* s = scr + (8 * c) * 33 + n;
        u32x4 o; o.x = pk2(s[0 * 33] * ga[0], s[1 * 33] * ga[1]); o.y = pk2(s[2 * 33] * ga[2], s[3 * 33] * ga[3]); o.z = pk2(s[4 * 33] * gb[0], s[5 * 33] * gb[1]); o.w = pk2(s[6 * 33] * gb[2], s[7 * 33] * gb[3]);
        const int col = n0 + n; int drow = col;
        if (mode == 1) { const int c2 = col < DFF ? col : col - DFF; drow = (c2 >> 7) * 256 + (col < DFF ? 0 : 128) + (c2 & 127); }
        *(u32x4*)(WT + (size_t)drow * K + k0 + 8 * c) = o; }
    asm volatile("s_waitcnt lgkmcnt(0)" ::: "memory");
}
__device__ __forceinline__ void rms_row_to_bf16(const float* xrow, const float* g, bf16_t* orow, int lane) {
    const f32x4* xr = (const f32x4*)xrow + lane; const f32x4* gr = (const f32x4*)g + lane;
    f32x4 v[8]; float s = 0.f;
#pragma unroll
    for (int j = 0; j < 8; ++j) { v[j] = xr[64 * j]; s += (v[j][0] * v[j][0] + v[j][1] * v[j][1]) + (v[j][2] * v[j][2] + v[j][3] * v[j][3]); }
    const float rstd = 1.0f / sqrtf(wave_sum(s) * (1.0f / DM) + EPS);
    u32x2* o8 = (u32x2*)orow + lane;
#pragma unroll
    for (int j = 0; j < 8; ++j) { const f32x4 gg = gr[64 * j]; u32x2 w; w.x = pk2(v[j][0] * rstd * gg[0], v[j][1] * rstd * gg[1]); w.y = pk2(v[j][2] * rstd * gg[2], v[j][3] * rstd * gg[3]); o8[64 * j] = w; }
}

__device__ __forceinline__ void s5_disc(const float* lam_re, const float* lam_im, int g, int p, float dt, float& are, float& aim, float& cre, float& cim) {
    const float lr = lam_re[g * 64 + p], li = lam_im[g * 64 + p];
    const float mag = expf(lr * dt);
    float sn, cs; sincos_rev((double)(li * dt) * 0.15915494309189533577, sn, cs);
    are = mag * cs; aim = mag * sn;
    const float den = lr * lr + li * li, am1 = are - 1.0f;
    cre = (am1 * lr + aim * li) / den; cim = (aim * lr - am1 * li) / den;
}

constexpr int SSM_WAVE_LDS = 12800 + 4096;
static_assert(8 * SSM_WAVE_LDS <= 146432, "SSM LDS vs the control words at the top of the allocation");
__device__ __forceinline__ void ssm_wave(const PTab a, LAS unsigned char* wl, bool sample, int bsel, int g, int lane) {
    const bf16_t* Z = (const bf16_t*)(AWS + WS_Z); bf16_t* YG = (bf16_t*)(AWS + WS_YG);
    const float *lam_re = AIN(13), *lam_im = AIN(14), *b_re = AIN(16), *b_im = AIN(17), *c_re = AIN(18), *c_im = AIN(19);
    LAS float* X = (LAS float*)wl; LAS bf16_t* Sb = (LAS bf16_t*)(wl + 8448);
    const int r16 = lane & 15, q4 = lane >> 4;
    const float dt = expf(AIN(15)[g]);
    float are, aim, tcr, tci; s5_disc(lam_re, lam_im, g, lane, dt, are, aim, tcr, tci);
    bf16x8 Bf[8];
#pragma unroll
    for (int blk = 0; blk < 8; ++blk) {
        const int p = 8 * blk + (r16 >> 1), c = r16 & 1;
        float d0, d1, cr, ci; s5_disc(lam_re, lam_im, g, p, dt, d0, d1, cr, ci);
        const float* br = b_re + ((size_t)g * 64 + p) * 16 + 8 * (q4 & 1); const float* bi = b_im + ((size_t)g * 64 + p) * 16 + 8 * (q4 & 1);
        bf16x8 f;
#pragma unroll
        for (int j = 0; j < 8; ++j) { const float v = c == 0 ? (cr * br[j] - ci * bi[j]) : (cr * bi[j] + ci * br[j]);
            const unsigned hi = f2bf(v); const float lo = v - __builtin_bit_cast(float, hi << 16);
            f[j] = (short)(q4 < 2 ? hi : f2bf(lo)); }
        Bf[blk] = f;
    }
    bf16x8 Cf[4];
#pragma unroll
    for (int kk = 0; kk < 4; ++kk) { bf16x8 f;
#pragma unroll
        for (int j = 0; j < 8; ++j) { const int p = 16 * kk + 4 * q4 + (j >> 1); const size_t ix = ((size_t)g * 16 + r16) * 64 + p;
            const float v = (j & 1) ? -c_im[ix] : c_re[ix]; f[j] = (short)f2bf(v); }
        Cf[kk] = f; }
    bf16x8 Df;
    { const float dsk = AIN(20)[g * 16 + r16]; const unsigned dhi = f2bf(dsk); const unsigned dlo = f2bf(dsk - __builtin_bit_cast(float, dhi << 16));
#pragma unroll
      for (int j = 0; j < 8; ++j) { const int kk = 8 * (q4 & 1) + j; Df[j] = (short)(kk == r16 ? (q4 < 2 ? dhi : dlo) : 0u); } }
    float sre = 0.f, sim = 0.f;
    const int nblk = sample ? 1 : TP / 16;
    const int rowbase = sample ? NPR + 16 * bsel : bsel * TP;
    const bf16_t* up = Z + (size_t)(rowbase + r16) * ZP + 16 * g + 8 * (q4 & 1);
    LAS bf16_t* Yb = (LAS bf16_t*)(wl + 12800);
    const int nch = (nblk + 7) / 8;
    bf16x8 Uc[8], Un[8];
#pragma unroll
    for (int i = 0; i < 8; ++i) { Uc[i] = (bf16x8){0, 0, 0, 0, 0, 0, 0, 0}; if (i < nblk) Uc[i] = *(const bf16x8*)(up + (size_t)(16 * i) * ZP); Un[i] = Uc[i]; }
    for (int ch = 0; ch < nch; ++ch) {
        const int nb = (nblk - 8 * ch) < 8 ? (nblk - 8 * ch) : 8;
        if (ch + 1 < nch) {
#pragma unroll
            for (int i = 0; i < 8; ++i) if (8 * (ch + 1) + i < nblk) Un[i] = *(const bf16x8*)(up + (size_t)(16 * (8 * (ch + 1) + i)) * ZP);
        }
#pragma unroll
        for (int i = 0; i < 8; ++i) {
            if (i < nb) {
                const bf16x8 Uf = Uc[i];
#pragma unroll
                for (int b8 = 0; b8 < 8; ++b8) {
                    f32x4 d = (f32x4){0.f, 0.f, 0.f, 0.f};
                    d = __builtin_amdgcn_mfma_f32_16x16x32_bf16(Bf[b8], Uf, d, 0, 0, 0);
                    *(LAS f32x4*)(X + r16 * 132 + 16 * b8 + 4 * q4) = d;
                }
                if (!sample) {
                    f32x2 xs[16];
#pragma unroll
                    for (int t = 0; t < 16; ++t) xs[t] = *(const LAS f32x2*)(X + t * 132 + 2 * lane);
#pragma unroll
                    for (int t = 0; t < 16; ++t) {
                        const float nr = are * sre - aim * sim + xs[t][0], ni = are * sim + aim * sre + xs[t][1];
                        sre = nr; sim = ni;
                        *(LAS unsigned*)(Sb + t * 136 + 2 * lane) = pk2(nr, ni);
                    }
                } else {
                    for (int t = 0; t < 16; ++t) {
                        const int s = 16 * bsel + t; const size_t ix = ((size_t)s * 64 + g) * 64 + lane;
                        const float h0r = AIN(4)[ix], h0i = AIN(5)[ix];
                        const f32x2 x = *(const LAS f32x2*)(X + t * 132 + 2 * lane);
                        const float nr = are * h0r - aim * h0i + x[0], ni = are * h0i + aim * h0r + x[1];
                        AOUT[O_SRE + ix] = nr; AOUT[O_SIM + ix] = ni;
                        *(LAS unsigned*)(Sb + t * 136 + 2 * lane) = pk2(nr, ni);
                    }
                }
                f32x4 y = (f32x4){0.f, 0.f, 0.f, 0.f};
                y = __builtin_amdgcn_mfma_f32_16x16x32_bf16(Uf, Df, y, 0, 0, 0);
#pragma unroll
                for (int kk = 0; kk < 4; ++kk) { const bf16x8 Af = *(const LAS bf16x8*)(Sb + r16 * 136 + 32 * kk + 8 * q4); y = __builtin_amdgcn_mfma_f32_16x16x32_bf16(Af, Cf[kk], y, 0, 0, 0); }
#pragma unroll
                for (int r = 0; r < 4; ++r) Yb[(16 * i + 4 * q4 + r) * 16 + r16] = (bf16_t)(pk2(gelu_tanh(y[r]), 0.f) & 0xffffu);
            }
        }
#pragma unroll
        for (int k = 0; k < 4; ++k) { const int rr = (lane >> 1) + 32 * k;
            if (rr < 16 * nb) *(u32x4*)(YG + (size_t)(rowbase + 128 * ch + rr) * DSSM + 16 * g + 8 * (lane & 1)) = *(const LAS u32x4*)(Yb + rr * 16 + 8 * (lane & 1)); }
#pragma unroll
        for (int i = 0; i < 8; ++i) Uc[i] = Un[i];
    }
    if (!sample) { const size_t ix = ((size_t)bsel * 64 + g) * 64 + lane; AOUT[O_PRE + ix] = sre; AOUT[O_PIM + ix] = sim; }
}


constexpr int PAIR_LDS = 8448 + 4 * 4352 + 4096 + 64;
constexpr int PAIR_RING = 8448, PAIR_YB = 8448 + 4 * 4352, PAIR_FLG = PAIR_YB + 4096;
static_assert(4 * PAIR_LDS <= 146432, "S5 pair regions vs the control words at the top of the allocation");
__device__ __forceinline__ void ssm_scan_role(const PTab a, LAS unsigned char* pl, int b, int g, int lane) {
    const bf16_t* Z = (const bf16_t*)(AWS + WS_Z);
    const float *lam_re = AIN(13), *lam_im = AIN(14), *b_re = AIN(16), *b_im = AIN(17);
    LAS float* X = (LAS float*)pl; volatile LAS unsigned* flg = (volatile LAS unsigned*)(pl + PAIR_FLG);
    const int r16 = lane & 15, q4 = lane >> 4;
    const float dt = expf(AIN(15)[g]);
    float are, aim, tcr, tci; s5_disc(lam_re, lam_im, g, lane, dt, are, aim, tcr, tci);
    bf16x8 Bf[8];
#pragma unroll
    for (int blk = 0; blk < 8; ++blk) {
        const int p = 8 * blk + (r16 >> 1), c = r16 & 1;
        float d0, d1, cr, ci; s5_disc(lam_re, lam_im, g, p, dt, d0, d1, cr, ci);
        const float* br = b_re + ((size_t)g * 64 + p) * 16 + 8 * (q4 & 1); const float* bi = b_im + ((size_t)g * 64 + p) * 16 + 8 * (q4 & 1);
        bf16x8 f;
#pragma unroll
        for (int j = 0; j < 8; ++j) { const float v = c == 0 ? (cr * br[j] - ci * bi[j]) : (cr * bi[j] + ci * br[j]);
            const unsigned hi = f2bf(v); const float lo = v - __builtin_bit_cast(float, hi << 16);
            f[j] = (short)(q4 < 2 ? hi : f2bf(lo)); }
        Bf[blk] = f;
    }
    float sre = 0.f, sim = 0.f;
    constexpr int nblk = TP / 16, nch = (nblk + 7) / 8;
    const int rowbase = b * TP;
    const bf16_t* up = Z + (size_t)(rowbase + r16) * ZP + 16 * g + 8 * (q4 & 1);
    bf16x8 Uc[8], Un[8];
#pragma unroll
    for (int i = 0; i < 8; ++i) { Uc[i] = *(const bf16x8*)(up + (size_t)(16 * i) * ZP); Un[i] = Uc[i]; }
    for (int ch = 0; ch < nch; ++ch) {
        const int nb = (nblk - 8 * ch) < 8 ? (nblk - 8 * ch) : 8;
        if (ch + 1 < nch) {
#pragma unroll
            for (int i = 0; i < 8; ++i) if (8 * (ch + 1) + i < nblk) Un[i] = *(const bf16x8*)(up + (size_t)(16 * (8 * (ch + 1) + i)) * ZP);
        }
#pragma unroll
        for (int i = 0; i < 8; ++i) {
            if (i < nb) {
                const int blk = 8 * ch + i;
#pragma unroll
                for (int b8 = 0; b8 < 8; ++b8) {
                    f32x4 d = (f32x4){0.f, 0.f, 0.f, 0.f};
                    d = __builtin_amdgcn_mfma_f32_16x16x32_bf16(Bf[b8], Uc[i], d, 0, 0, 0);
                    *(LAS f32x4*)(X + r16 * 132 + 16 * b8 + 4 * q4) = d;
                }
                f32x2 xs[16];
#pragma unroll
                for (int t = 0; t < 16; ++t) xs[t] = *(const LAS f32x2*)(X + t * 132 + 2 * lane);
                if (blk >= 4) { unsigned sp = 0; while (flg[1] < (unsigned)(blk - 3)) { __builtin_amdgcn_s_sleep(1); if (++sp > (1u << 22)) break; } }
                asm volatile("" ::: "memory");
                LAS bf16_t* Sw = (LAS bf16_t*)(pl + PAIR_RING + (i & 3) * 4352);
#pragma unroll
                for (int t = 0; t < 16; ++t) {
                    const float nr = are * sre - aim * sim + xs[t][0], ni = are * sim + aim * sre + xs[t][1];
                    sre = nr; sim = ni;
                    *(LAS unsigned*)(Sw + t * 136 + 2 * lane) = pk2(nr, ni);
                }
                asm volatile("s_waitcnt lgkmcnt(0)" ::: "memory");
                if (lane == 0) flg[0] = (unsigned)(blk + 1);
            }
        }
#pragma unroll
        for (int i = 0; i < 8; ++i) Uc[i] = Un[i];
    }
    { const size_t ix = ((size_t)b * 64 + g) * 64 + lane; AOUT[O_PRE + ix] = sre; AOUT[O_PIM + ix] = sim; }
}
__device__ __forceinline__ void ssm_out_role(const PTab a, LAS unsigned char* pl, int b, int g, int lane) {
    const bf16_t* Z = (const bf16_t*)(AWS + WS_Z); bf16_t* YG = (bf16_t*)(AWS + WS_YG);
    const float *c_re = AIN(18), *c_im = AIN(19);
    volatile LAS unsigned* flg = (volatile LAS unsigned*)(pl + PAIR_FLG); LAS bf16_t* Yb = (LAS bf16_t*)(pl + PAIR_YB);
    const int r16 = lane & 15, q4 = lane >> 4;
    bf16x8 Cf[4];
#pragma unroll
    for (int kk = 0; kk < 4; ++kk) { bf16x8 f;
#pragma unroll
        for (int j = 0; j < 8; ++j) { const int p = 16 * kk + 4 * q4 + (j >> 1); const size_t ix = ((size_t)g * 16 + r16) * 64 + p;
            const float v = (j & 1) ? -c_im[ix] : c_re[ix]; f[j] = (short)f2bf(v); }
        Cf[kk] = f; }
    bf16x8 Df;
    { const float dsk = AIN(20)[g * 16 + r16]; const unsigned dhi = f2bf(dsk); const unsigned dlo = f2bf(dsk - __builtin_bit_cast(float, dhi << 16));
#pragma unroll
      for (int j = 0; j < 8; ++j) { const int kk = 8 * (q4 & 1) + j; Df[j] = (short)(kk == r16 ? (q4 < 2 ? dhi : dlo) : 0u); } }
    constexpr int nblk = TP / 16, nch = (nblk + 7) / 8;
    const int rowbase = b * TP;
    const bf16_t* up = Z + (size_t)(rowbase + r16) * ZP + 16 * g + 8 * (q4 & 1);
    bf16x8 Uc[8], Un[8];
#pragma unroll
    for (int i = 0; i < 8; ++i) { Uc[i] = *(const bf16x8*)(up + (size_t)(16 * i) * ZP); Un[i] = Uc[i]; }
    for (int ch = 0; ch < nch; ++ch) {
        const int nb = (nblk - 8 * ch) < 8 ? (nblk - 8 * ch) : 8;
        if (ch + 1 < nch) {
#pragma unroll
            for (int i = 0; i < 8; ++i) if (8 * (ch + 1) + i < nblk) Un[i] = *(const bf16x8*)(up + (size_t)(16 * (8 * (ch + 1) + i)) * ZP);
        }
#pragma unroll
        for (int i = 0; i < 8; ++i) {
            if (i < nb) {
                const int blk = 8 * ch + i;
                { unsigned sp = 0; while (flg[0] < (unsigned)(blk + 1)) { __builtin_amdgcn_s_sleep(1); if (++sp > (1u << 22)) break; } }
                asm volatile("" ::: "memory");
                const LAS bf16_t* Sr = (const LAS bf16_t*)(pl + PAIR_RING + (i & 3) * 4352);
                bf16x8 Af[4];
#pragma unroll
                for (int kk = 0; kk < 4; ++kk) Af[kk] = *(const LAS bf16x8*)(Sr + r16 * 136 + 32 * kk + 8 * q4);
                asm volatile("s_waitcnt lgkmcnt(0)" ::: "memory");
                if (lane == 0) flg[1] = (unsigned)(blk + 1);
                f32x4 y = (f32x4){0.f, 0.f, 0.f, 0.f};
                y = __builtin_amdgcn_mfma_f32_16x16x32_bf16(Uc[i], Df, y, 0, 0, 0);
#pragma unroll
                for (int kk = 0; kk < 4; ++kk) y = __builtin_amdgcn_mfma_f32_16x16x32_bf16(Af[kk], Cf[kk], y, 0, 0, 0);
#pragma unroll
                for (int r = 0; r < 4; ++r) Yb[(16 * i + 4 * q4 + r) * 16 + r16] = (bf16_t)(pk2(gelu_tanh(y[r]), 0.f) & 0xffffu);
            }
        }
#pragma unroll
        for (int k = 0; k < 4; ++k) { const int rr = (lane >> 1) + 32 * k;
            if (rr < 16 * nb) *(u32x4*)(YG + (size_t)(rowbase + 128 * ch + rr) * DSSM + 16 * g + 8 * (lane & 1)) = *(const LAS u32x4*)(Yb + rr * 16 + 8 * (lane & 1)); }
#pragma unroll
        for (int i = 0; i < 8; ++i) Uc[i] = Un[i];
    }
}

__device__ __forceinline__ void attn_prompt_unit(const PTab a, LAS unsigned char* lds, int b, int kh, int qb, int tid) {
    const bf16_t* Z = (const bf16_t*)(AWS + WS_Z); bf16_t* MIX = (bf16_t*)(AWS + WS_MIX); float* ssqA = (float*)(AWS + WS_SSQA);
    const f32x2* rope = (const f32x2*)(AWS + WS_ROPE);
    const float *qg = AIN(10), *kg = AIN(11);
    LAS bf16_t* KT = (LAS bf16_t*)lds; LAS bf16_t* VT = (LAS bf16_t*)(lds + 27648);
    const int t0 = qb * 64, tk0 = t0 - 128;
    const int wave = tid >> 6, lane = tid & 63;
    const int head = kh * 4 + (wave & 3), half = wave >> 2, r32 = lane & 31, hf = lane >> 5;
    const int tq0 = t0 + 32 * half, tq = tq0 + r32; const bool qvalid = tq < TP;
    const int qrow = b * TP + (qvalid ? tq : TP - 1);
    u32x4 qraw[4];
    { const bf16_t* qp = Z + (size_t)qrow * ZP + 1024 + head * 64 + 8 * hf;
#pragma unroll
      for (int ks = 0; ks < 4; ++ks) qraw[ks] = *(const u32x4*)(qp + 16 * ks); }
    __syncthreads();
#pragma unroll 1
    for (int pass = 0; pass < 3; ++pass) {
        const int idx = pass * 512 + tid, key = idx >> 3, i = idx & 7, t = tk0 + key; const bool valid = t >= 0 && t < TP;
        u32x2 r1 = (u32x2){0u, 0u}, r2 = r1;
        if (valid) { const bf16_t* kp = Z + (size_t)(b * TP + t) * ZP + 2048 + kh * 64; r1 = *(const u32x2*)(kp + 4 * i); r2 = *(const u32x2*)(kp + 32 + 4 * i); }
        float x1[4] = {bflo(r1.x), bfhi(r1.x), bflo(r1.y), bfhi(r1.y)}, x2[4] = {bflo(r2.x), bfhi(r2.x), bflo(r2.y), bfhi(r2.y)};
        float ss = 0.f;
#pragma unroll
        for (int e = 0; e < 4; ++e) ss += x1[e] * x1[e] + x2[e] * x2[e];
        ss += __shfl_xor(ss, 1); ss += __shfl_xor(ss, 2); ss += __shfl_xor(ss, 4);
        const float rstd = 1.0f / sqrtf(ss * (1.0f / 64.0f) + EPS);
        float o1[4], o2[4];
        const f32x4* rp = (const f32x4*)(rope + (size_t)(valid ? t : 0) * 32 + 4 * i);
        const f32x4 ra = rp[0], rb = rp[1]; const float cs_c[4] = {ra[0], ra[2], rb[0], rb[2]}, cs_s[4] = {ra[1], ra[3], rb[1], rb[3]};
        const f32x4 g1 = *(const f32x4*)(kg + 4 * i), g2 = *(const f32x4*)(kg + 32 + 4 * i);
#pragma unroll
        for (int e = 0; e < 4; ++e) {
            const float y1 = x1[e] * rstd * g1[e], y2 = x2[e] * rstd * g2[e];
            o1[e] = y1 * cs_c[e] - y2 * cs_s[e]; o2[e] = y1 * cs_s[e] + y2 * cs_c[e]; }
        u32x2 w1, w2; w1.x = pk2(o1[0], o1[1]); w1.y = pk2(o1[2], o1[3]); w2.x = pk2(o2[0], o2[1]); w2.y = pk2(o2[2], o2[3]);
        *(LAS u32x2*)(KT + key * 72 + 4 * i) = w1; *(LAS u32x2*)(KT + key * 72 + 32 + 4 * i) = w2;
        if (valid && key >= 128 && t >= TP - 128) { float* po = AOUT + O_PK + (((size_t)b * 128 + (t - (TP - 128))) * 4 + kh) * 64;
            *(f32x4*)(po + 4 * i) = (f32x4){o1[0], o1[1], o1[2], o1[3]}; *(f32x4*)(po + 32 + 4 * i) = (f32x4){o2[0], o2[1], o2[2], o2[3]}; }
    }
#pragma unroll 1
    for (int pass = 0; pass < 3; ++pass) {
        const int idx = pass * 512 + tid, key = idx >> 3, j = idx & 7, t = tk0 + key; const bool valid = t >= 0 && t < TP;
        u32x4 r = (u32x4){0u, 0u, 0u, 0u};
        if (valid) r = *(const u32x4*)(Z + (size_t)(b * TP + t) * ZP + 2304 + kh * 64 + 8 * j);
        const unsigned w[4] = {r.x, r.y, r.z, r.w};
#pragma unroll
        for (int e = 0; e < 4; ++e) { VT[(8 * j + 2 * e) * 200 + key] = (bf16_t)(w[e] & 0xffffu); VT[(8 * j + 2 * e + 1) * 200 + key] = (bf16_t)(w[e] >> 16); }
        if (valid && key >= 128 && t >= TP - 128) { float* po = AOUT + O_PV + (((size_t)b * 128 + (t - (TP - 128))) * 4 + kh) * 64 + 8 * j;
            *(f32x4*)(po) = (f32x4){bflo(r.x), bfhi(r.x), bflo(r.y), bfhi(r.y)}; *(f32x4*)(po + 4) = (f32x4){bflo(r.z), bfhi(r.z), bflo(r.w), bfhi(r.w)}; }
    }
    __syncthreads();
    float qv[4][8];
    { float ss = 0.f;
#pragma unroll
      for (int ks = 0; ks < 4; ++ks) { const u32x4 r = qraw[ks];
          qv[ks][0] = bflo(r.x); qv[ks][1] = bfhi(r.x); qv[ks][2] = bflo(r.y); qv[ks][3] = bfhi(r.y); qv[ks][4] = bflo(r.z); qv[ks][5] = bfhi(r.z); qv[ks][6] = bflo(r.w); qv[ks][7] = bfhi(r.w);
#pragma unroll
          for (int j = 0; j < 8; ++j) ss += qv[ks][j] * qv[ks][j]; }
      ss += __shfl_xor(ss, 32);
      const float rstd = 0.125f / sqrtf(ss * (1.0f / 64.0f) + EPS);
#pragma unroll
      for (int ks = 0; ks < 2; ++ks) {
          const f32x4* rp = (const f32x4*)(rope + (size_t)(qvalid ? tq : TP - 1) * 32 + 16 * ks + 8 * hf);
          const f32x4* gp1 = (const f32x4*)(qg + 16 * ks + 8 * hf); const f32x4* gp2 = (const f32x4*)(qg + 32 + 16 * ks + 8 * hf);
#pragma unroll
          for (int jj = 0; jj < 4; ++jj) { const f32x4 cs2 = rp[jj]; const f32x4 ga = gp1[jj >> 1], gb = gp2[jj >> 1];
#pragma unroll
              for (int e = 0; e < 2; ++e) { const int j = 2 * jj + e; const float c = cs2[2 * e], sn = cs2[2 * e + 1];
                  const float y1 = qv[ks][j] * rstd * ga[(j & 3)], y2 = qv[ks + 2][j] * rstd * gb[(j & 3)];
                  qv[ks][j] = y1 * c - y2 * sn; qv[ks + 2][j] = y1 * sn + y2 * c; } } } }
    bf16x8 qf[4];
#pragma unroll
    for (int ks = 0; ks < 4; ++ks)
#pragma unroll
        for (int j = 0; j < 8; ++j) qf[ks][j] = (short)f2bf(qv[ks][j]);
    const int wk0 = 32 * half;
    const float sink = AIN(12)[head];
    float mx = sink;
#pragma unroll 1
    for (int kb = 0; kb < 5; ++kb) {
        f32x16 s;
#pragma unroll
        for (int r = 0; r < 16; ++r) s[r] = 0.f;
#pragma unroll
        for (int ks = 0; ks < 4; ++ks) { const bf16x8 kf = *(const LAS bf16x8*)(KT + (wk0 + 32 * kb + r32) * 72 + 16 * ks + 8 * hf);
            s = __builtin_amdgcn_mfma_f32_32x32x16_bf16(kf, qf[ks], s, 0, 0, 0); }
#pragma unroll
        for (int r = 0; r < 16; ++r) { const int i = (r & 3) + 8 * (r >> 2) + 4 * hf; const int diff = 128 + r32 - 32 * kb - i; const int kp = tq - diff;
            const bool ok = diff >= 0 && diff < 128 && kp >= 0; mx = fmaxf(mx, ok ? s[r] : -1e30f); }
    }
    mx = fmaxf(mx, __shfl_xor(mx, 32));
    float lsum = 0.f;
    f32x16 oacc[2];
#pragma unroll
    for (int db = 0; db < 2; ++db)
#pragma unroll
        for (int r = 0; r < 16; ++r) oacc[db][r] = 0.f;
#pragma unroll 1
    for (int kb = 0; kb < 5; ++kb) {
        f32x16 s;
#pragma unroll
        for (int r = 0; r < 16; ++r) s[r] = 0.f;
#pragma unroll
        for (int ks = 0; ks < 4; ++ks) { const bf16x8 kf = *(const LAS bf16x8*)(KT + (wk0 + 32 * kb + r32) * 72 + 16 * ks + 8 * hf);
            s = __builtin_amdgcn_mfma_f32_32x32x16_bf16(kf, qf[ks], s, 0, 0, 0); }
#pragma unroll
        for (int r = 0; r < 16; ++r) { const int i = (r & 3) + 8 * (r >> 2) + 4 * hf; const int diff = 128 + r32 - 32 * kb - i; const int kp = tq - diff;
            const bool ok = diff >= 0 && diff < 128 && kp >= 0; const float p = ok ? __expf(s[r] - mx) : 0.f; s[r] = p; lsum += p; }
#pragma unroll
        for (int s2 = 0; s2 < 2; ++s2) {
            bf16x8 pf;
#pragma unroll
            for (int j = 0; j < 8; ++j) pf[j] = (short)f2bf(s[8 * s2 + j]);
#pragma unroll
            for (int db = 0; db < 2; ++db) {
                const LAS bf16_t* vp = VT + (32 * db + r32) * 200 + wk0 + 32 * kb + 16 * s2 + 4 * hf;
                const u32x2 v0 = *(const LAS u32x2*)vp, v1 = *(const LAS u32x2*)(vp + 8);
                u32x4 vv; vv.x = v0.x; vv.y = v0.y; vv.z = v1.x; vv.w = v1.y;
                oacc[db] = __builtin_amdgcn_mfma_f32_32x32x16_bf16(__builtin_bit_cast(bf16x8, vv), pf, oacc[db], 0, 0, 0);
            }
        }
    }
    lsum += __shfl_xor(lsum, 32);
    lsum += __expf(sink - mx);
    const float inv = 1.0f / lsum; float ss = 0.f;
#pragma unroll
    for (int db = 0; db < 2; ++db)
#pragma unroll
        for (int r = 0; r < 16; ++r) { const float o = oacc[db][r] * inv; oacc[db][r] = o; ss += o * o; }
    ss += __shfl_xor(ss, 32);
    if (qvalid) {
        bf16_t* op = MIX + (size_t)qrow * DM + 1024 + head * 64;
#pragma unroll
        for (int db = 0; db < 2; ++db)
#pragma unroll
            for (int g4 = 0; g4 < 4; ++g4) { u32x2 w; w.x = pk2(oacc[db][4 * g4], oacc[db][4 * g4 + 1]); w.y = pk2(oacc[db][4 * g4 + 2], oacc[db][4 * g4 + 3]);
                *(u32x2*)(op + 32 * db + 8 * g4 + 4 * hf) = w; }
        if (hf == 0) unsafeAtomicAdd(ssqA + qrow, ss);
    }
}

__device__ __forceinline__ void attn_sample_unit(const PTab a, LAS unsigned char* lds, int s, int tid) {
    const bf16_t* Z = (const bf16_t*)(AWS + WS_Z); bf16_t* MIX = (bf16_t*)(AWS + WS_MIX); float* ssqA = (float*)(AWS + WS_SSQA);
    const f32x2* rope = (const f32x2*)(AWS + WS_ROPE) + (size_t)TP * 32;
    LAS float* qs = (LAS float*)lds;
    LAS float* kn = qs + 1024;
    LAS float* vn = kn + 256;
    LAS float* sc = vn + 256;
    LAS float* red = sc + 2048;
    const int wave = tid >> 6, lane = tid & 63, row = NPR + s;
    const bf16_t* zr = Z + (size_t)row * ZP;
    __syncthreads();
    const f32x2 cs = rope[lane & 31];
#pragma unroll 1
    for (int hh = 0; hh < 2; ++hh) { const int h = 2 * wave + hh; const float v = bf2f(zr[1024 + h * 64 + lane]);
        const float rstd = 1.0f / sqrtf(wave_sum(v * v) * (1.0f / 64.0f) + EPS); const float x = v * rstd * AIN(10)[lane]; const float pr = __shfl_xor(x, 32);
        const float o = lane < 32 ? x * cs[0] - pr * cs[1] : pr * cs[1] + x * cs[0]; qs[h * 64 + lane] = o * 0.125f; }
    if (wave < 4) { const int kh = wave; const float v = bf2f(zr[2048 + kh * 64 + lane]);
        const float rstd = 1.0f / sqrtf(wave_sum(v * v) * (1.0f / 64.0f) + EPS); const float x = v * rstd * AIN(11)[lane]; const float pr = __shfl_xor(x, 32);
        const float o = lane < 32 ? x * cs[0] - pr * cs[1] : pr * cs[1] + x * cs[0]; kn[kh * 64 + lane] = o;
        AOUT[O_SK + (((size_t)s * 128 + 127) * 4 + kh) * 64 + lane] = o;
        const float vv = bf2f(zr[2304 + kh * 64 + lane]); vn[kh * 64 + lane] = vv; AOUT[O_SV + (((size_t)s * 128 + 127) * 4 + kh) * 64 + lane] = vv; }
    __syncthreads();
    { const int j = tid & 127, kh = tid >> 7; float acc4[4] = {0.f, 0.f, 0.f, 0.f};
      const float* kp = AIN(2) + (((size_t)s * 128 + (j < 127 ? j + 1 : 127)) * 4 + kh) * 64;
#pragma unroll 4
      for (int d4 = 0; d4 < 16; ++d4) { f32x4 kv; if (j < 127) kv = *(const f32x4*)(kp + 4 * d4); else kv = *(const LAS f32x4*)(kn + kh * 64 + 4 * d4);
#pragma unroll
          for (int hq = 0; hq < 4; ++hq) { const f32x4 q = *(const LAS f32x4*)(qs + (kh * 4 + hq) * 64 + 4 * d4); acc4[hq] += (kv[0] * q[0] + kv[1] * q[1]) + (kv[2] * q[2] + kv[3] * q[3]); } }
#pragma unroll
      for (int hq = 0; hq < 4; ++hq) sc[(kh * 4 + hq) * 128 + j] = acc4[hq]; }
    __syncthreads();
#pragma unroll 1
    for (int hh = 0; hh < 2; ++hh) { const int h = 2 * wave + hh; const float v0 = sc[h * 128 + lane], v1 = sc[h * 128 + 64 + lane]; const float sink = AIN(12)[h];
        const float m = fmaxf(wave_max(fmaxf(v0, v1)), sink); const float p0 = __expf(v0 - m), p1 = __expf(v1 - m);
        const float inv = 1.0f / (wave_sum(p0 + p1) + __expf(sink - m)); sc[h * 128 + lane] = p0 * inv; sc[h * 128 + 64 + lane] = p1 * inv; }
    __syncthreads();
    { const int d4 = tid & 15, kh = (tid >> 4) & 3, jp = tid >> 6; f32x4 acc4[4];
#pragma unroll
      for (int hq = 0; hq < 4; ++hq) acc4[hq] = (f32x4){0.f, 0.f, 0.f, 0.f};
#pragma unroll 4
      for (int jj = 0; jj < 16; ++jj) { const int j = jp * 16 + jj; f32x4 vv;
          if (j < 127) vv = *(const f32x4*)(AIN(3) + (((size_t)s * 128 + j + 1) * 4 + kh) * 64 + 4 * d4); else vv = *(const LAS f32x4*)(vn + kh * 64 + 4 * d4);
#pragma unroll
          for (int hq = 0; hq < 4; ++hq) acc4[hq] += sc[(kh * 4 + hq) * 128 + j] * vv; }
#pragma unroll
      for (int hq = 0; hq < 4; ++hq) *(LAS f32x4*)(red + (jp * 16 + kh * 4 + hq) * 64 + 4 * d4) = acc4[hq]; }
    __syncthreads();
    { const int h = tid >> 5, d2 = tid & 31; float o0 = 0.f, o1 = 0.f;
#pragma unroll
      for (int jp = 0; jp < 8; ++jp) { o0 += red[(jp * 16 + h) * 64 + d2]; o1 += red[(jp * 16 + h) * 64 + 32 + d2]; }
      float ss = o0 * o0 + o1 * o1;
#pragma unroll
      for (int o = 1; o < 32; o <<= 1) ss += __shfl_xor(ss, o);
      MIX[(size_t)row * DM + 1024 + h * 64 + d2] = (bf16_t)f2bf(o0); MIX[(size_t)row * DM + 1024 + h * 64 + 32 + d2] = (bf16_t)f2bf(o1);
      if (d2 == 0) unsafeAtomicAdd(ssqA + row, ss); }
}


#define XB_TMO      128
#define XB_XCNT(j)  (256  + 64 * (j))
#define XB_XSUB(j)  (1280 + 64 * (j))
#define XB_XGEN(j)  (2304 + 64 * (j))
#define XB_TOP      3328
#define XB_TOPGEN   3392
#define XCD_BAR_WORDS 3456
#define XB_SPIN_CAP (1u << 22)
__device__ __forceinline__ unsigned xb_ld(unsigned* p)              { return __hip_atomic_load(p, __ATOMIC_RELAXED, __HIP_MEMORY_SCOPE_AGENT); }
__device__ __forceinline__ unsigned xb_add(unsigned* p, unsigned v) { return __hip_atomic_fetch_add(p, v, __ATOMIC_RELAXED, __HIP_MEMORY_SCOPE_AGENT); }
__device__ __forceinline__ unsigned xb_xcc_id() { return (unsigned)__builtin_amdgcn_s_getreg((3 << 11) | 20) & 0xFu; }
#define XB_SPIN(cond, bar) do { unsigned _sp = 0; while (cond) { __builtin_amdgcn_s_sleep(1); \
    if ((++_sp & 255u) == 0u) { if (xb_ld(&(bar)[XB_TMO])) break; if (_sp > XB_SPIN_CAP) { atomicAdd(&(bar)[XB_TMO], 1u); break; } } } } while (0)
struct XcdBarrier { unsigned* bar; unsigned x; volatile LAS unsigned* st; };
__device__ __forceinline__ XcdBarrier xcd_barrier_post(unsigned* bar, volatile LAS unsigned* st) {
    XcdBarrier b; b.bar = bar; b.x = xb_xcc_id(); b.st = st;
    if (threadIdx.x == 0) (void)xb_add(&bar[XB_XCNT(b.x)], 1u);
    return b;
}
__device__ __forceinline__ void xcd_barrier_complete(unsigned* bar, unsigned x, unsigned& nloc, unsigned& nx) {
    const unsigned G = gridDim.x * gridDim.y * gridDim.z;
    unsigned sum, cnt, mine, sp = 0u;
    for (;;) {
        sum = 0u; cnt = 0u; mine = 0u;
#pragma unroll
        for (unsigned j = 0; j < 16; ++j) { const unsigned c = xb_ld(&bar[XB_XCNT(j)]); sum += c; cnt += (c > 0u) ? 1u : 0u; mine = (j == x) ? c : mine; }
        if (sum == G) break;
        __builtin_amdgcn_s_sleep(1);
        if ((++sp & 255u) == 0u) { if (xb_ld(&bar[XB_TMO])) break; if (sp > XB_SPIN_CAP) { atomicAdd(&bar[XB_TMO], 1u); break; } }
    }
    nloc = mine > 0u ? mine : 1u; nx = cnt > 0u ? cnt : 1u;
}
__device__ __forceinline__ void xcd_barrier(const XcdBarrier& b) {
    asm volatile("s_waitcnt vmcnt(0)" ::: "memory");
    __syncthreads();
    if (threadIdx.x == 0) {
        unsigned* bar = b.bar;
        __builtin_amdgcn_s_waitcnt(0);
        unsigned nloc = b.st[0], nx = b.st[1];
        if (nloc == 0u) { xcd_barrier_complete(bar, b.x, nloc, nx); b.st[0] = nloc; b.st[1] = nx; }
        const unsigned old = xb_add(&bar[XB_XSUB(b.x)], 1u);
        const unsigned gen = old / nloc;
        if (old + 1u == (gen + 1u) * nloc) {
            __builtin_amdgcn_fence(__ATOMIC_RELEASE, "agent");
            asm volatile("s_waitcnt vmcnt(0)" ::: "memory");
            const unsigned og = xb_add(&bar[XB_TOP], 1u);
            const unsigned tg = og / nx;
            if (og + 1u == (tg + 1u) * nx) xb_add(&bar[XB_TOPGEN], 1u);
            else XB_SPIN(xb_ld(&bar[XB_TOPGEN]) == tg, bar);
            __builtin_amdgcn_fence(__ATOMIC_ACQUIRE, "agent");
            xb_add(&bar[XB_XGEN(b.x)], 1u);
            asm volatile("s_waitcnt vmcnt(0)" ::: "memory");
        } else {
            XB_SPIN(xb_ld(&bar[XB_XGEN(b.x)]) == gen, bar);
            __builtin_amdgcn_fence(__ATOMIC_ACQUIRE, "agent");
            asm volatile("s_waitcnt vmcnt(0)" ::: "memory");
        }
    }
    __syncthreads();
}

__global__ void __launch_bounds__(512, 2) hymba_fwd(Args ka) {
    extern __shared__ __attribute__((aligned(16))) unsigned char lds_raw[];
    LAS unsigned char* lds = (LAS unsigned char*)lds_raw;
    cg::grid_group grid = cg::this_grid();
    const int tid = threadIdx.x, lane = tid & 63, wave = __builtin_amdgcn_readfirstlane(tid >> 6);
    const int G = gridDim.x, bx = blockIdx.x;
    const int gw = bx * 8 + wave, NGW = G * 8;
    const PTab a = (PTab)(lds + 146432 + 128);
#pragma unroll
    for (int i = 0; i < 31; ++i) if (tid == i) a[i] = (unsigned long long)ka.in[i];
    if (tid == 31) a[31] = (unsigned long long)ka.out;
    if (tid == 32) a[32] = (unsigned long long)ka.ws;
    __syncthreads();
    unsigned char* ws = AWS;
    volatile LAS unsigned* bst = (volatile LAS unsigned*)(lds + 146432 + 64);
    if (tid < 2) bst[tid] = 0u;
    __syncthreads();
    const XcdBarrier xbar = xcd_barrier_post((unsigned*)(ws + WS_CTL), bst);
#define GSYNC() xcd_barrier(xbar)
    bf16_t* WinT = (bf16_t*)(ws + WS_WIN); bf16_t* WgluT = (bf16_t*)(ws + WS_WGLU); bf16_t* WoutT = (bf16_t*)(ws + WS_WOUT); bf16_t* WupT = (bf16_t*)(ws + WS_WUP); bf16_t* WdownT = (bf16_t*)(ws + WS_WDOWN);
    bf16_t* H = (bf16_t*)(ws + WS_H) + 2 * DM;
    bf16_t* Z = (bf16_t*)(ws + WS_Z); bf16_t* YG = (bf16_t*)(ws + WS_YG); bf16_t* MIX = (bf16_t*)(ws + WS_MIX); bf16_t* ACT = (bf16_t*)(ws + WS_ACT);
    float* XMID = (float*)(ws + WS_XMID); float* ssqS = (float*)(ws + WS_SSQS); float* ssqA = (float*)(ws + WS_SSQA);

#ifndef ONLY
#define ONLY -1
#endif
#define PHON(k) (ONLY < 0 || ONLY == (k))
#ifndef PROBE_PHASE
#define PROBE_PHASE -1
#endif
#define REP(k) for (int rep_ = 0; rep_ < ((PROBE_PHASE == (k)) ? 2 : 1); ++rep_)
    REP(0) if (PHON(0)) {
        LAS float* scr = (LAS float*)(lds + wave * 16384);
        constexpr int I_IN = (DM / 64) * (DIN / 32), I_GLU = (DSSM / 64) * (DSSM / 32), I_OUT = (DM / 64) * (DM / 32), I_UP = (DM / 64) * (DFF2 / 32), I_DN = (DFF / 64) * (DM / 32);
        constexpr int NITEMS = I_IN + I_GLU + I_OUT;
        for (int it = gw; it < I_IN; it += NGW) transpose_item(AIN(9), DM, DIN, WinT, 0, nullptr, nullptr, scr, it, lane);
        for (int m = gw; m < MROWS; m += NGW) rms_row_to_bf16(pg8::xrow_ptr(AIN(0), AIN(1), AIN(7), m), AIN(8), H + (size_t)m * DM, lane);
        f32x2* rope = (f32x2*)(ws + WS_ROPE);
        for (int e = bx * 512 + tid; e < NROPE * 32; e += G * 512) {
            const int pi = e >> 5, i = e & 31; const int pos = pi < TP ? pi : PASTLEN;
            double inv = 1.0; for (int k = 0; k < i; ++k) inv *= 0.74989420933245582730;
            const float ang = (float)pos * (float)inv; float sn, cs; sincos_rev((double)ang * 0.15915494309189533577, sn, cs);
            rope[e] = (f32x2){cs, sn};
        }
        for (int e = bx * 512 + tid; e < MROWS; e += G * 512) { ssqS[e] = 0.f; ssqA[e] = 0.f; }
    }
    grid.sync();
    if (PHON(1)) { typedef pg8::Order<MROWS / 256, DIN / 256, DM / 64, false> Ord; Ord S; S.init(G, bx); pg8::EpiZ E{a};
      pg8::gemm_phase<pg8::EpiZ, false, Ord>(lds, H, WinT, S, E);
      constexpr int NU = (MROWS / 256) * (DIN / 256); const int nrem = NU % G;
      if (nrem > 0 && bx >= nrem) { LAS float* scr = (LAS float*)(lds + wave * 16384); constexpr int I_UP = (DM / 64) * (DFF2 / 32);
          for (int it = (bx - nrem) * 8 + wave; it < I_UP; it += (G - nrem) * 8) transpose_item(AIN(27), DM, DFF2, WupT, 1, nullptr, nullptr, scr, it, lane); }
      else if (nrem == 0) { LAS float* scr = (LAS float*)(lds + wave * 16384); constexpr int I_UP = (DM / 64) * (DFF2 / 32);
          for (int it = gw; it < I_UP; it += NGW) transpose_item(AIN(27), DM, DFF2, WupT, 1, nullptr, nullptr, scr, it, lane); } }
    GSYNC();
    if (PHON(2)) {
        constexpr int NSSM = 128;
        if (bx < NSSM) {
            LAS unsigned char* pl = lds + (wave & 3) * PAIR_LDS;
            if (wave < 4 && lane < 2) ((volatile LAS unsigned*)(pl + PAIR_FLG))[lane] = 0u;
            __syncthreads();
#ifndef NO_SSM
            const int un = bx * 4 + (wave & 3);
            if (wave < 4) { ssm_wave(a, pl, true, un >> 6, un & 63, lane);
                            ssm_scan_role(a, pl, un >> 6, un & 63, lane); }
            else ssm_out_role(a, pl, un >> 6, un & 63, lane);
#endif
        } else {
            const int nA = NB * 4 * 33, nTot = nA + NS;
#pragma unroll 1
            for (int it = bx - NSSM; it < nTot; it += G - NSSM) {
                if (it < nA) {
#ifndef NO_AP
                    const int b = it / 132, r = it - b * 132; attn_prompt_unit(a, lds, b, r / 33, r % 33, tid);
#endif
                } else {
#ifndef NO_AS
                    attn_sample_unit(a, lds, it - nA, tid);
#endif
                }
            }
        }
            __syncthreads();
            { LAS float* scr = (LAS float*)(lds + wave * 16384);
              const int cw = bx * 8 + wave, NCW = G * 8;
              constexpr int I_GLU = (DSSM / 64) * (DSSM / 32), I_OUT = (DM / 64) * (DM / 32), I_DN = (DFF / 64) * (DM / 32);
              for (int it = cw; it < I_GLU + I_OUT + I_DN; it += NCW) {
                  if (it < I_GLU) transpose_item(AIN(21), DSSM, DSSM, WgluT, 0, nullptr, nullptr, scr, it, lane);
                  else if (it < I_GLU + I_OUT) transpose_item(AIN(25), DM, DM, WoutT, 0, AIN(23), AIN(24), scr, it - I_GLU, lane);
                  else transpose_item(AIN(30), DFF, DM, WdownT, 0, nullptr, nullptr, scr, it - I_GLU - I_OUT, lane); }
              for (int e = cw * 64 + lane; e < NS * 127 * 64; e += NCW * 64) { const int s = e / (127 * 64), rj = e - s * (127 * 64), j = rj >> 6, c4 = rj & 63;
                  const size_t so = ((size_t)s * 128 + j + 1) * 256 + 4 * c4, dd = ((size_t)s * 128 + j) * 256 + 4 * c4;
                  *(f32x4*)(AOUT + O_SK + dd) = *(const f32x4*)(AIN(2) + so); *(f32x4*)(AOUT + O_SV + dd) = *(const f32x4*)(AIN(3) + so); } }
    }
    GSYNC();
    if (PHON(3)) { typedef pg8::Order<MROWS / 256, DSSM / 256, DSSM / 64, true> Ord; Ord S; S.init(G, bx); pg8::EpiGlu E{a, S.nsplit()};
      pg8::gemm_phase<pg8::EpiGlu, false, Ord>(lds, YG, WgluT, S, E);
      { pg8::Unit pu; if (S.piece(pu)) E.finish(pu); } }
    GSYNC();
    if (PHON(4)) { typedef pg8::Order<MROWS / 256, DM / 256, DM / 64, true> Ord; Ord S; S.init(G, bx); pg8::EpiOut E{a, S.nsplit(), ws};
      pg8::gemm_phase<pg8::EpiOut, false, Ord>(lds, MIX, WoutT, S, E);
      { pg8::Unit pu; if (S.piece(pu)) E.finish(pu); } }
    GSYNC();
    if (PHON(5)) for (int m = gw; m < MROWS; m += NGW) rms_row_to_bf16(XMID + (size_t)m * DM, AIN(26), H + (size_t)m * DM, lane);
    GSYNC();
    if (PHON(6)) { typedef pg8::Order<68, DFF2 / 256, DM / 64, false> Ord; Ord S; S.init(G, bx); pg8::EpiUp E{a, lds};
      pg8::gemm_phase<pg8::EpiUp, true, Ord>(lds, H - 2 * DM, WupT, S, E); }
    GSYNC();
    if (PHON(7)) { typedef pg8::Order<MROWS / 256, DM / 256, DFF / 64, true> Ord; Ord S; S.init(G, bx); pg8::EpiDown E{a, S.nsplit()};
      pg8::gemm_phase<pg8::EpiDown, false, Ord>(lds, ACT, WdownT, S, E);
      { pg8::Unit pu; if (S.piece(pu)) E.finish(pu); } }
}

extern "C" void kernel_launch(void* const* d_in, const int* in_sizes, int n_in, void* d_out, int out_size, void* d_ws, size_t ws_size, hipStream_t stream) {
    static int grid = 0;
    if (grid == 0) {
        if (n_in != 31 || (size_t)out_size != O_END || ws_size < WS_END) { fprintf(stderr, "kernel_launch: unexpected shapes: n_in %d out %d (want %zu) ws %zu (want %zu)\n", n_in, out_size, (size_t)O_END, ws_size, (size_t)WS_END); grid = -1; return; }
        int dev = 0, cus = 0, per_cu = 0;
        (void)hipGetDevice(&dev); (void)hipDeviceGetAttribute(&cus, hipDeviceAttributeMultiprocessorCount, dev);
        if (hipFuncSetAttribute((const void*)hymba_fwd, hipFuncAttributeMaxDynamicSharedMemorySize, LDS_BYTES) != hipSuccess) { fprintf(stderr, "kernel_launch: hipFuncSetAttribute failed\n"); grid = -1; return; }
        (void)hipOccupancyMaxActiveBlocksPerMultiprocessor(&per_cu, (const void*)hymba_fwd, 512, LDS_BYTES);
        if (per_cu < 1) { fprintf(stderr, "kernel_launch: occupancy query says %d blocks per CU\n", per_cu); per_cu = 1; }
        (void)hipGetLastError();
        grid = cus;
    }
    if (grid < 0) return;
    if (hipMemsetAsync((char*)d_ws + WS_CTL, 0, CTL_BYTES, stream) != hipSuccess) { fprintf(stderr, "kernel_launch: memset failed\n"); return; }
    Args a{};
    for (int i = 0; i < 31; ++i) a.in[i] = (const float*)d_in[i];
    a.out = (float*)d_out; a.ws = (unsigned char*)d_ws;
    void* args[] = {&a};
    hipError_t e = hipLaunchCooperativeKernel((const void*)hymba_fwd, dim3(grid), dim3(512), args, LDS_BYTES, stream);
    if (e != hipSuccess) fprintf(stderr, "kernel_launch: cooperative launch failed: %s (grid %d)\n", hipGetErrorString(e), grid);
}
```

```cpp
#include <hip/hip_runtime.h>
#include <hip/hip_cooperative_groups.h>
#include <cstdio>
#include <cstdint>
namespace cg = cooperative_groups;

#define LAS __attribute__((address_space(3)))
typedef unsigned short bf16_t;
typedef short bf16x8 __attribute__((ext_vector_type(8)));
typedef float f32x4 __attribute__((ext_vector_type(4)));
typedef float f32x2 __attribute__((ext_vector_type(2)));
typedef float f32x16 __attribute__((ext_vector_type(16)));
typedef unsigned u32x4 __attribute__((ext_vector_type(4)));
typedef unsigned u32x2 __attribute__((ext_vector_type(2)));

constexpr int DM = 2048, NB = 8, SEQ = 2048, NMETA = 16, TP = SEQ + NMETA, NPR = NB * TP, NS = 128, MROWS = NPR + NS;
constexpr int DSSM = 1024, DATT = 1024, DKV = 256, DIN = 2560, DFF = 5632, DFF2 = 11264, ZP = DIN;
constexpr int PASTLEN = 16384, NROPE = TP + 1;
constexpr float EPS = 1e-6f;
static_assert(MROWS % 256 == 0, "rows");

constexpr size_t WS_WIN = 0;
constexpr size_t WS_WGLU = WS_WIN + (size_t)DIN * DM * 2;
constexpr size_t WS_WOUT = WS_WGLU + (size_t)DSSM * DSSM * 2;
constexpr size_t WS_WUP = WS_WOUT + (size_t)DM * DM * 2;
constexpr size_t WS_WDOWN = WS_WUP + (size_t)DFF2 * DM * 2;
constexpr size_t WS_ROPE = WS_WDOWN + (size_t)DM * DFF * 2;
constexpr size_t WS_CTL = WS_ROPE + 786432, CTL_BYTES = 32768;
constexpr size_t WS_SSQS = WS_ROPE + (1u << 20);
constexpr size_t WS_SSQA = WS_SSQS + (size_t)MROWS * 16 * 4;
constexpr size_t WS_H = WS_SSQA + (size_t)MROWS * 16 * 4;
constexpr size_t H_ROWS = 17000;
constexpr size_t WS_Z = WS_H + H_ROWS * DM * 2;
constexpr size_t WS_YG = WS_Z + (size_t)MROWS * ZP * 2;
constexpr size_t WS_MIX = WS_YG + (size_t)MROWS * DSSM * 2;
constexpr size_t WS_ACT = WS_Z;
constexpr size_t WS_XMID = WS_MIX + (size_t)MROWS * DM * 2;
constexpr size_t WS_END = WS_XMID + (size_t)MROWS * DM * 4;
static_assert(WS_ACT + (size_t)MROWS * DFF * 2 <= WS_XMID, "ACT overlay");
static_assert(WS_WGLU % 256 == 0 && WS_WOUT % 256 == 0 && WS_WUP % 256 == 0 && WS_WDOWN % 256 == 0 && WS_ROPE % 256 == 0 && WS_H % 256 == 0 && WS_Z % 256 == 0 && WS_XMID % 256 == 0, "align");

constexpr size_t O_YP = 0, O_YS = O_YP + (size_t)NB * SEQ * DM, O_PK = O_YS + (size_t)NS * DM, O_PV = O_PK + (size_t)NB * 128 * 256,
                 O_PRE = O_PV + (size_t)NB * 128 * 256, O_PIM = O_PRE + (size_t)NB * 64 * 64, O_PCONV = O_PIM + (size_t)NB * 64 * 64,
                 O_SK = O_PCONV + (size_t)NB * 2 * DFF2, O_SV = O_SK + (size_t)NS * 128 * 256, O_SRE = O_SV + (size_t)NS * 128 * 256,
                 O_SIM = O_SRE + (size_t)NS * 64 * 64, O_SCONV = O_SIM + (size_t)NS * 64 * 64, O_END = O_SCONV + (size_t)NS * 2 * DFF2;

constexpr int LDS_BYTES = 147456;

struct Args {
    const float* in[31];
    float* out;
    unsigned char* ws;
};

__device__ __forceinline__ unsigned f2bf(float f) { unsigned u = __builtin_bit_cast(unsigned, f); return (u + 0x7fffu + ((u >> 16) & 1u)) >> 16; }
typedef __bf16 bf16x2_t __attribute__((ext_vector_type(2)));
__device__ __forceinline__ unsigned pk2(float lo, float hi) { const f32x2 v = {lo, hi}; return __builtin_bit_cast(unsigned, __builtin_convertvector(v, bf16x2_t)); }
__device__ __forceinline__ float bf2f(unsigned short b) { return __builtin_bit_cast(float, (unsigned)b << 16); }
__device__ __forceinline__ float bflo(unsigned w) { return __builtin_bit_cast(float, w << 16); }
__device__ __forceinline__ float bfhi(unsigned w) { return __builtin_bit_cast(float, w & 0xffff0000u); }
__device__ __forceinline__ float wave_sum(float v) {
#pragma unroll
    for (int o = 1; o < 64; o <<= 1) v += __shfl_xor(v, o);
    return v;
}
__device__ __forceinline__ float wave_max(float v) {
#pragma unroll
    for (int o = 1; o < 64; o <<= 1) v = fmaxf(v, __shfl_xor(v, o));
    return v;
}
__device__ __forceinline__ void sincos_rev(double rev, float& s, float& c) {
    double r = rev - __builtin_floor(rev);
    double q = __builtin_floor(r * 4.0 + 0.5);
    double x = (r - q * 0.25) * 6.283185307179586476925;
    double x2 = x * x;
    double sp = x * (1.0 + x2 * (-1.0 / 6 + x2 * (1.0 / 120 + x2 * (-1.0 / 5040 + x2 * (1.0 / 362880 + x2 * (-1.0 / 39916800 + x2 * (1.0 / 6227020800.0)))))));
    double cp = 1.0 + x2 * (-0.5 + x2 * (1.0 / 24 + x2 * (-1.0 / 720 + x2 * (1.0 / 40320 + x2 * (-1.0 / 3628800 + x2 * (1.0 / 479001600 + x2 * (-1.0 / 87178291200.0)))))));
    int qi = ((int)q) & 3;
    double ss = (qi == 0) ? sp : (qi == 1) ? cp : (qi == 2) ? -sp : -cp;
    double cc = (qi == 0) ? cp : (qi == 1) ? -sp : (qi == 2) ? -cp : sp;
    s = (float)ss; c = (float)cc;
}
__device__ __forceinline__ float gelu_tanh(float y) {
    float z = 0.7978845608028654f * (y + 0.044715f * y * y * y);
    float e = __expf(2.0f * z);
    float th = 1.0f - 2.0f * __builtin_amdgcn_rcpf(e + 1.0f);
    return 0.5f * y * (1.0f + th);
}
__device__ __forceinline__ float sigmoidf_(float v) { return __builtin_amdgcn_rcpf(1.0f + __expf(-v)); }


typedef LAS unsigned long long* PTab;
__device__ __forceinline__ unsigned long long rfl64(unsigned long long v) { const unsigned lo = __builtin_amdgcn_readfirstlane((unsigned)v), hi = __builtin_amdgcn_readfirstlane((unsigned)(v >> 32)); return ((unsigned long long)hi << 32) | lo; }
#define GAS __attribute__((address_space(1)))
#define AIN(i) ((const float*)(const GAS float*)rfl64(a[(i)]))
#define AOUT ((float*)(GAS float*)rfl64(a[31]))
#define AWS ((unsigned char*)(GAS unsigned char*)rfl64(a[32]))

namespace pg8 {
constexpr int BM = 256, BK = 64, HALF = 128, HTB = HALF * BK * 2, STAGE_BYTES = 8 * HTB, NXCD = 8, WGM = 8;
__device__ __forceinline__ int lds_byte(int r, int c) { const int st = (r >> 4) * 2 + (c >> 5), rr = r & 15, cc = c & 31, ob = rr * 64 + cc * 2; return st * 1024 + (ob ^ (((ob >> 9) & 1) << 5)); }
__device__ __forceinline__ void stage_rc(int b, int& R, int& C) { const int st = b / 1024, sb = b % 1024, swz = sb ^ (((sb >> 9) & 1) << 5); R = (st >> 1) * 16 + swz / 64; C = (st & 1) * 32 + (swz % 64) / 2; }
__device__ __forceinline__ int perm32(int rho) { const int n = rho >> 4, i = rho & 15; return 8 * (i >> 2) + 4 * n + (i & 3); }

struct Unit { int pm, pn, k0, nk, sj, sc; };

template <int NM, int NN, int NT, bool SPLIT>
struct Order {
    static constexpr int nM = NM, nN = NN, nt = NT, nwg = NM * NN;
    int G, c;
    __device__ __forceinline__ void init(int G_, int c_) { G = G_; c = c_; }
    __device__ __forceinline__ int nfull() const { return SPLIT ? nwg - nwg % G : nwg; }
    __device__ __forceinline__ int cs() const { if (!SPLIT) return NT; const int R = nwg % G; if (R == 0) return NT; const int per = G / R; return 2 * (((NT / 2) + per - 1) / per); }
    __device__ __forceinline__ int nsplit() const { const int c_ = cs(); return (NT + c_ - 1) / c_; }
    __device__ __forceinline__ void map(int L, int& pm, int& pn) const {
        int wgid = L; { const int q = nwg / NXCD, r = nwg % NXCD, xcd = wgid % NXCD, off = wgid / NXCD; wgid = (xcd < r ? xcd * (q + 1) : r * (q + 1) + (xcd - r) * q) + off; }
        const int nig = WGM * nN, gid = wgid / nig, fm = gid * WGM, gsz = (nM - fm) < WGM ? (nM - fm) : WGM;
        pm = fm + ((wgid % nig) % gsz); pn = (wgid % nig) / gsz;
    }
    __device__ __forceinline__ int npieces() const { return SPLIT ? (nwg - nfull()) * nsplit() : 0; }
    __device__ __forceinline__ bool next(int i, Unit& u) const {
        const int nf = nfull(), np = npieces();
        const bool haspc = SPLIT && c < np;
        const bool ispc = haspc && i == 1;
        const int iw = (haspc && i >= 2) ? i - 1 : i;
        const int L = iw * G + c;
        const bool full = !ispc && L < nf;
        const int S = SPLIT ? nsplit() : 1, cs_ = SPLIT ? cs() : NT;
        const int p = c, sj = ispc ? p / S : 0, sc = ispc ? p - sj * S : 0;
        int pm, pn; map(ispc ? nf + sj : (full ? L : 0), pm, pn);
        const int k0 = ispc ? sc * cs_ : 0;
        const int nk = ispc ? ((NT - k0) < cs_ ? (NT - k0) : cs_) : NT;
        u = Unit{pm, pn, k0, nk, sj, sc};
        return ispc || full;
    }
    __device__ __forceinline__ bool piece(Unit& u) const { if (!(SPLIT && c < npieces())) return false; return next(1, u); }
};

__device__ __forceinline__ unsigned cvt_pk_bf16(float lo, float hi) { unsigned r; asm volatile("v_cvt_pk_bf16_f32 %0, %1, %2" : "=v"(r) : "v"(lo), "v"(hi)); return r; }

template <class Epi, bool ACHUNK, class Ord>
__device__ __forceinline__ void gemm_phase(LAS unsigned char* lds, const bf16_t* gA, const bf16_t* gBt, const Ord& S, const Epi& E) {
    int tid = threadIdx.x; asm volatile("" : "+v"(tid));
    const int wid = __builtin_amdgcn_readfirstlane(tid >> 6), lane = tid & 63, wr = wid >> 2, wc = wid & 3, fr = lane & 15, fq = lane >> 4;
    constexpr int K = Ord::nt * BK, ntot = Ord::nt;
    unsigned voffA[2], voffB[2];
#pragma unroll
    for (int i = 0; i < 2; ++i) { int R, C; stage_rc(tid * 16 + i * 8192, R, C); const int Rb = Epi::PERM ? ((R & ~31) + perm32(R & 31)) : R;
        const int Ra = ACHUNK ? (62 * (R >> 6) + (R & 63)) : R;
        voffA[i] = (unsigned)(Ra * K + C) * 2u; voffB[i] = (unsigned)(Rb * K + C) * 2u; }
    const size_t kstep = (size_t)(BK * 2);
    const size_t hsB = (size_t)HALF * K * 2, tsB = 2 * hsB;
    const size_t hsA = ACHUNK ? (size_t)124 * K * 2 : hsB, tsA = 2 * hsA;
    const unsigned ldsw = (unsigned)wid * 1024u;
    const int aoff = lds_byte(wr * 64 + fr, fq * 8), boff = lds_byte(wc * 32 + fr, fq * 8);
#define PG8_SA(b, h) (((b) * 2 + (h)) * HTB)
#define PG8_SB(b, h) ((4 + (b) * 2 + (h)) * HTB)
#define PG8_STAGE(bufoff, gbase, voff) do { _Pragma("unroll") for (int _i = 0; _i < 2; ++_i) \
        __builtin_amdgcn_global_load_lds((const unsigned*)((const char*)(gbase) + (voff)[_i]), (LAS unsigned*)(lds + (bufoff) + ldsw + _i * 8192), 16, 0, 0); } while (0)
#define PG8_LDA(dst, b, h) do { _Pragma("unroll") for (int m = 0; m < 4; ++m) _Pragma("unroll") for (int k = 0; k < 2; ++k) dst[m][k] = *(const LAS bf16x8*)(lds + PG8_SA(b, h) + aoff + m * 2048 + k * 1024); } while (0)
#define PG8_LDB(dst, b, h) do { _Pragma("unroll") for (int n = 0; n < 2; ++n) _Pragma("unroll") for (int k = 0; k < 2; ++k) dst[n][k] = *(const LAS bf16x8*)(lds + PG8_SB(b, h) + boff + n * 2048 + k * 1024); } while (0)
#define PG8_MMA(ai, bj, At, Bt) do { __builtin_amdgcn_s_setprio(1); _Pragma("unroll") for (int m = 0; m < 4; ++m) _Pragma("unroll") for (int n = 0; n < 2; ++n) _Pragma("unroll") for (int k = 0; k < 2; ++k) \
        acc[ai][bj][m][n] = __builtin_amdgcn_mfma_f32_16x16x32_bf16(Bt[n][k], At[m][k], acc[ai][bj][m][n], 0, 0, 0); __builtin_amdgcn_s_setprio(0); } while (0)
#define PG8_WAIT_V(n) asm volatile("s_waitcnt vmcnt(" #n ")" ::: "memory")
#define PG8_WAIT_L(n) asm volatile("s_waitcnt lgkmcnt(" #n ")" ::: "memory")
#define PG8_BAR __builtin_amdgcn_s_barrier()
#define PG8_SCHED __builtin_amdgcn_sched_barrier(0)
    Unit cur, nxt; int ui = 0;
    if (!S.next(0, cur)) return;
    f32x4 acc[2][2][4][2];
#pragma unroll
    for (int a = 0; a < 2; ++a)
#pragma unroll
        for (int b = 0; b < 2; ++b)
#pragma unroll
            for (int m = 0; m < 4; ++m)
#pragma unroll
                for (int n = 0; n < 2; ++n) acc[a][b][m][n] = (f32x4){0.f, 0.f, 0.f, 0.f};
    bf16x8 At[4][2], B0[2][2], B1[2][2];
    const char* cA = (const char*)gA + (size_t)cur.pm * tsA + (size_t)cur.k0 * kstep; const char* cB = (const char*)gBt + (size_t)cur.pn * tsB + (size_t)cur.k0 * kstep;
    PG8_STAGE(PG8_SB(0, 0), cB, voffB); PG8_STAGE(PG8_SB(0, 1), cB + hsB, voffB); PG8_STAGE(PG8_SA(0, 0), cA, voffA); PG8_STAGE(PG8_SA(0, 1), cA + hsA, voffA);
    if (wr == 1) PG8_BAR;
    PG8_WAIT_V(2); PG8_BAR;
    PG8_STAGE(PG8_SB(1, 0), cB + kstep, voffB); PG8_STAGE(PG8_SA(1, 0), cA + kstep, voffA); PG8_STAGE(PG8_SB(1, 1), cB + hsB + kstep, voffB);
    PG8_WAIT_V(6); PG8_BAR;
    for (;;) {
        const bool has_next = S.next(ui + 1, nxt);
        const char* nA = has_next ? (const char*)gA + (size_t)nxt.pm * tsA + (size_t)nxt.k0 * kstep : cA; const char* nB = has_next ? (const char*)gBt + (size_t)nxt.pn * tsB + (size_t)nxt.k0 * kstep : cB;
        const int nt = cur.nk;
        for (int t = 0; t < nt; t += 2) {
            const bool last = (t == nt - 2);
            const char* a1 = cA + (size_t)(t + 1) * kstep;
            const char* a2 = last ? nA : cA + (size_t)(t + 2) * kstep; const char* b2 = last ? nB : cB + (size_t)(t + 2) * kstep;
            const char* a3 = a2 + kstep; const char* b3 = b2 + kstep;
            if constexpr (Epi::MIDK) { if (t == ntot / 2 && nt == ntot) E.mid(acc, cur, wr, wc, fr, fq); }
            if constexpr (Epi::PRELOAD) { if (last) E.preload(cur, lds, tid); }
            PG8_LDB(B0, 0, 0); PG8_LDB(B1, 0, 1); PG8_SCHED; PG8_LDA(At, 0, 0); PG8_STAGE(PG8_SA(1, 1), a1 + hsA, voffA);
            PG8_WAIT_V(8); PG8_WAIT_L(0); PG8_BAR; PG8_MMA(0, 0, At, B0); PG8_MMA(0, 1, At, B1); PG8_BAR; PG8_SCHED;
            PG8_LDA(At, 0, 1); PG8_STAGE(PG8_SB(0, 0), b2, voffB); PG8_STAGE(PG8_SB(0, 1), b2 + hsB, voffB); PG8_STAGE(PG8_SA(0, 0), a2, voffA);
            PG8_WAIT_V(8); PG8_WAIT_L(0); PG8_BAR; PG8_MMA(1, 0, At, B0); PG8_MMA(1, 1, At, B1); PG8_BAR; PG8_SCHED;
            PG8_LDB(B0, 1, 0); PG8_LDB(B1, 1, 1); PG8_SCHED; PG8_LDA(At, 1, 0); PG8_STAGE(PG8_SA(0, 1), a2 + hsA, voffA);
            PG8_WAIT_V(8); PG8_WAIT_L(0); PG8_BAR; PG8_MMA(0, 0, At, B0); PG8_MMA(0, 1, At, B1); PG8_BAR; PG8_SCHED;
            PG8_LDA(At, 1, 1); PG8_STAGE(PG8_SB(1, 0), b3, voffB); PG8_STAGE(PG8_SB(1, 1), b3 + hsB, voffB); PG8_STAGE(PG8_SA(1, 0), a3, voffA);
            PG8_WAIT_V(8); PG8_WAIT_L(0); PG8_BAR; PG8_MMA(1, 0, At, B0); PG8_MMA(1, 1, At, B1); PG8_BAR; PG8_SCHED;
        }
        if (wr == 0) PG8_BAR;
        E(acc, cur, wr, wc, fr, fq);
        if (!has_next) break;
#pragma unroll
        for (int a = 0; a < 2; ++a)
#pragma unroll
            for (int b = 0; b < 2; ++b)
#pragma unroll
                for (int m = 0; m < 4; ++m)
#pragma unroll
                    for (int n = 0; n < 2; ++n) acc[a][b][m][n] = (f32x4){0.f, 0.f, 0.f, 0.f};
        cur = nxt; cA = nA; cB = nB; ++ui;
        if (wr == 1) PG8_BAR;
    }
    PG8_WAIT_V(0);
    PG8_BAR;
#undef PG8_SA
#undef PG8_SB
#undef PG8_STAGE
#undef PG8_LDA
#undef PG8_LDB
#undef PG8_MMA
#undef PG8_WAIT_V
#undef PG8_WAIT_L
#undef PG8_BAR
#undef PG8_SCHED
}


__device__ __forceinline__ void store_wt(float* p, f32x4 v) {
    asm volatile("global_store_dwordx4 %0, %1, off sc1\n\ts_nop 1" :: "v"(p), "v"(v) : "memory");
}
__device__ __forceinline__ void part_rc(int idx, int& trow, int& tcol) {
    const int lane = idx & 63, wv = (idx >> 6) & 7, slot = idx >> 9, n = slot & 1, bj = (slot >> 1) & 1, m = (slot >> 2) & 3, ai = slot >> 4;
    trow = ai * 128 + (wv >> 2) * 64 + m * 16 + (lane & 15); tcol = bj * 128 + (wv & 3) * 32 + n * 16 + 4 * (lane >> 4);
}
__device__ __forceinline__ void split_publish(unsigned* cnt) {
    asm volatile("s_waitcnt vmcnt(0)" ::: "memory");
    __syncthreads();
    if (threadIdx.x == 0) __hip_atomic_fetch_add(cnt, 1u, __ATOMIC_RELAXED, __HIP_MEMORY_SCOPE_AGENT);
}
__device__ __forceinline__ void split_wait(unsigned* cnt, unsigned S) {
    if (threadIdx.x == 0) {
        unsigned sp = 0;
        while (__hip_atomic_load(cnt, __ATOMIC_RELAXED, __HIP_MEMORY_SCOPE_AGENT) < S) { __builtin_amdgcn_s_sleep(2); if (++sp > (1u << 22)) break; }
        __builtin_amdgcn_fence(__ATOMIC_ACQUIRE, "agent");
        asm volatile("s_waitcnt vmcnt(0)" ::: "memory");
    }
    __syncthreads();
}
struct EpiZ {
    static constexpr bool PERM = true, MIDK = false, PRELOAD = false;
    PTab a;
    __device__ __forceinline__ void operator()(const f32x4 (&acc)[2][2][4][2], const Unit& u, int wr, int wc, int fr, int fq) const {
        bf16_t* O = (bf16_t*)(AWS + WS_Z); constexpr int ldc = ZP;
        const int row0 = u.pm * BM + wr * 64 + fr, col0 = u.pn * BM + wc * 32 + 8 * fq;
#pragma unroll
        for (int ai = 0; ai < 2; ++ai)
#pragma unroll
            for (int m = 0; m < 4; ++m) { bf16_t* rowp = O + (size_t)(row0 + ai * HALF + m * 16) * ldc + col0;
#pragma unroll
                for (int bj = 0; bj < 2; ++bj) { const f32x4 v0 = acc[ai][bj][m][0], v1 = acc[ai][bj][m][1];
                    u32x4 w; w.x = cvt_pk_bf16(v0[0], v0[1]); w.y = cvt_pk_bf16(v0[2], v0[3]); w.z = cvt_pk_bf16(v1[0], v1[1]); w.w = cvt_pk_bf16(v1[2], v1[3]);
                    *(u32x4*)(rowp + bj * HALF) = w; } }
    }
};
struct EpiGlu {
    static constexpr bool PERM = true, MIDK = false, PRELOAD = false;
    PTab a; int S;
    __device__ __forceinline__ void operator()(const f32x4 (&acc)[2][2][4][2], const Unit& u, int wr, int wc, int fr, int fq) const {
        unsigned char* ws_ = AWS; const bf16_t* YG = (const bf16_t*)(ws_ + WS_YG); bf16_t* MIX = (bf16_t*)(ws_ + WS_MIX); const float* bglu = AIN(22); float* ssq = (float*)(ws_ + WS_SSQS);
        const int row0 = u.pm * BM + wr * 64 + fr, col0 = u.pn * BM + wc * 32 + 8 * fq;
        if (u.nk == DSSM / 64) {
#pragma unroll
        for (int ai = 0; ai < 2; ++ai)
#pragma unroll
            for (int m = 0; m < 4; ++m) { const int row = row0 + ai * HALF + m * 16; float ss = 0.f;
#pragma unroll
                for (int bj = 0; bj < 2; ++bj) { const int col = col0 + bj * HALF;
                    const u32x4 yv = *(const u32x4*)(YG + (size_t)row * DSSM + col);
                    const f32x4 b0 = *(const f32x4*)(bglu + col), b1 = *(const f32x4*)(bglu + col + 4);
                    const f32x4 v0 = acc[ai][bj][m][0] + b0, v1 = acc[ai][bj][m][1] + b1;
                    float o[8];
                    o[0] = bflo(yv.x) * sigmoidf_(v0[0]); o[1] = bfhi(yv.x) * sigmoidf_(v0[1]); o[2] = bflo(yv.y) * sigmoidf_(v0[2]); o[3] = bfhi(yv.y) * sigmoidf_(v0[3]);
                    o[4] = bflo(yv.z) * sigmoidf_(v1[0]); o[5] = bfhi(yv.z) * sigmoidf_(v1[1]); o[6] = bflo(yv.w) * sigmoidf_(v1[2]); o[7] = bfhi(yv.w) * sigmoidf_(v1[3]);
#pragma unroll
                    for (int e = 0; e < 8; ++e) ss += o[e] * o[e];
                    u32x4 w; w.x = cvt_pk_bf16(o[0], o[1]); w.y = cvt_pk_bf16(o[2], o[3]); w.z = cvt_pk_bf16(o[4], o[5]); w.w = cvt_pk_bf16(o[6], o[7]);
                    *(u32x4*)(MIX + (size_t)row * DM + col) = w; }
                ss += __shfl_xor(ss, 16); ss += __shfl_xor(ss, 32);
                if (fq == 0) unsafeAtomicAdd(ssq + row, ss); }
        } else {
            float* pt = (float*)(ws_ + WS_H) + ((size_t)(u.sj * S + u.sc) << 16) + 4 * (fr + 16 * fq) + 256 * (wr * 4 + wc);
#pragma unroll
            for (int ai = 0; ai < 2; ++ai)
#pragma unroll
                for (int m = 0; m < 4; ++m)
#pragma unroll
                    for (int bj = 0; bj < 2; ++bj)
#pragma unroll
                        for (int n = 0; n < 2; ++n) { store_wt(pt, acc[ai][bj][m][n]); pt += 2048; asm volatile("" : "+v"(pt)); }
            split_publish((unsigned*)(ws_ + WS_CTL + 16384 + 4096) + 64 * u.sj);
        }
    }
    __device__ __forceinline__ void finish(const Unit& u) const {
        unsigned char* ws_ = AWS; const bf16_t* YG = (const bf16_t*)(ws_ + WS_YG); bf16_t* MIX = (bf16_t*)(ws_ + WS_MIX); const float* bglu = AIN(22); float* ssq = (float*)(ws_ + WS_SSQS);
        split_wait((unsigned*)(ws_ + WS_CTL + 16384 + 4096) + 64 * u.sj, (unsigned)S);
        const int lo = u.sc * 16384 / S, hi = (u.sc + 1) * 16384 / S; const float* pb = (const float*)(ws_ + WS_H) + ((size_t)(u.sj * S) << 16);
        for (int idx = lo + (int)threadIdx.x; idx < hi; idx += 512) { f32x4 sum = (f32x4){0.f, 0.f, 0.f, 0.f};
            for (int c0 = 0; c0 < S; c0 += 8) {
                f32x4 pv[8];
#pragma unroll
                for (int k = 0; k < 8; ++k) pv[k] = (c0 + k < S) ? *(const f32x4*)(pb + ((size_t)(c0 + k) << 16) + 4 * idx) : (f32x4){0.f, 0.f, 0.f, 0.f};
#pragma unroll
                for (int k = 0; k < 8; ++k) sum += pv[k]; }
            const int lane = idx & 63, wv = (idx >> 6) & 7, slot = idx >> 9, n = slot & 1, bj = (slot >> 1) & 1, m = (slot >> 2) & 3, ai = slot >> 4;
            const int row = u.pm * BM + ai * 128 + (wv >> 2) * 64 + m * 16 + (lane & 15), col = u.pn * BM + bj * 128 + (wv & 3) * 32 + 8 * (lane >> 4) + 4 * n;
            const u32x2 yv = *(const u32x2*)(YG + (size_t)row * DSSM + col); const f32x4 bb = *(const f32x4*)(bglu + col); const f32x4 v = sum + bb;
            const float o0 = bflo(yv.x) * sigmoidf_(v[0]), o1 = bfhi(yv.x) * sigmoidf_(v[1]), o2 = bflo(yv.y) * sigmoidf_(v[2]), o3 = bfhi(yv.y) * sigmoidf_(v[3]);
            u32x2 w; w.x = pk2(o0, o1); w.y = pk2(o2, o3); *(u32x2*)(MIX + (size_t)row * DM + col) = w;
            unsafeAtomicAdd(ssq + row, (o0 * o0 + o1 * o1) + (o2 * o2 + o3 * o3)); }
    }
};
__device__ __forceinline__ float row_rs(const float* ssq, int row) { return 1.0f / sqrtf(ssq[row] * (1.0f / 1024.0f) + EPS); }
__device__ __forceinline__ const float* xrow_ptr(const float* xp, const float* xs, const float* meta, int row) {
    if (row >= NPR) return xs + (size_t)(row - NPR) * DM;
    const int b = row / TP, t = row - b * TP;
    return t < NMETA ? meta + (size_t)t * DM : xp + ((size_t)b * SEQ + (t - NMETA)) * DM;
}
struct EpiOut {
    static constexpr bool PERM = false, MIDK = true, PRELOAD = false;
    PTab a; int S; unsigned char* wsp;
    __device__ __forceinline__ void mid(f32x4 (&acc)[2][2][4][2], const Unit& u, int wr, int wc, int fr, int fq) const {
        unsigned char* ws_ = wsp; const float* ssqS = (const float*)(ws_ + WS_SSQS); const float* ssqA = (const float*)(ws_ + WS_SSQA);
        int rowb = u.pm * BM + wr * 64 + fr; asm volatile("" : "+v"(rowb));
#pragma unroll
        for (int ai = 0; ai < 2; ++ai)
#pragma unroll
            for (int m = 0; m < 4; ++m) { const int row = rowb + ai * HALF + m * 16; float ratio = row_rs(ssqS, row) / row_rs(ssqA, row);
                asm volatile("" : "+v"(ratio) :: "memory");
#pragma unroll
                for (int bj = 0; bj < 2; ++bj)
#pragma unroll
                    for (int n = 0; n < 2; ++n) acc[ai][bj][m][n] *= ratio;
                asm volatile("" : "+v"(acc[ai][0][m][0]), "+v"(acc[ai][0][m][1]), "+v"(acc[ai][1][m][0]), "+v"(acc[ai][1][m][1]) :: "memory"); }
    }
    __device__ __forceinline__ void operator()(const f32x4 (&acc)[2][2][4][2], const Unit& u, int wr, int wc, int fr, int fq) const {
        unsigned char* ws_ = AWS; const float* ssqS = (const float*)(ws_ + WS_SSQS); const float* ssqA = (const float*)(ws_ + WS_SSQA); float* xmid = (float*)(ws_ + WS_XMID);
        float* part = (float*)(ws_ + WS_H); unsigned* cnt = (unsigned*)(ws_ + WS_CTL + 16384); const float *xp = AIN(0), *xs = AIN(1), *meta = AIN(7);
        const int tcol0 = wc * 32 + 4 * fq;
        const bool whole = u.nk == DM / 64;
        if (whole) {
#pragma unroll
            for (int ai = 0; ai < 2; ++ai)
#pragma unroll
                for (int m = 0; m < 4; ++m) { const int trow = ai * HALF + wr * 64 + m * 16 + fr, row = u.pm * BM + trow;
                    const float rsa = row_rs(ssqA, row);
                    const float* src = xrow_ptr(xp, xs, meta, row) + u.pn * BM; float* dst = xmid + (size_t)row * DM + u.pn * BM;
#pragma unroll
                    for (int bj = 0; bj < 2; ++bj)
#pragma unroll
                        for (int n = 0; n < 2; ++n) { const int tcol = tcol0 + bj * HALF + n * 16; const f32x4 xr = *(const f32x4*)(src + tcol); *(f32x4*)(dst + tcol) = xr + rsa * acc[ai][bj][m][n]; } }
        } else {
            float* pt = part + ((size_t)(u.sj * S + u.sc) << 16) + 4 * (fr + 16 * fq) + 256 * (wr * 4 + wc);
            const float* ssq = u.k0 >= DM / 128 ? ssqA : ssqS;
#pragma unroll
            for (int ai = 0; ai < 2; ++ai)
#pragma unroll
                for (int m = 0; m < 4; ++m) { const int row = u.pm * BM + ai * HALF + wr * 64 + m * 16 + fr; const float rsa = row_rs(ssq, row);
#pragma unroll
                    for (int bj = 0; bj < 2; ++bj)
#pragma unroll
                        for (int n = 0; n < 2; ++n) { const f32x4 v = rsa * acc[ai][bj][m][n]; store_wt(pt, v); pt += 2048; asm volatile("" : "+v"(pt)); } }
        }
        if (!whole) split_publish(cnt + 64 * u.sj);
    }
    __device__ __forceinline__ void finish(const Unit& u) const {
        unsigned char* ws_ = AWS; float* xmid = (float*)(ws_ + WS_XMID); float* part = (float*)(ws_ + WS_H); unsigned* cnt = (unsigned*)(ws_ + WS_CTL + 16384); const float *xp = AIN(0), *xs = AIN(1), *meta = AIN(7);
        split_wait(cnt + 64 * u.sj, (unsigned)S);
        const int lo = u.sc * 16384 / S, hi = (u.sc + 1) * 16384 / S; const float* pb = part + ((size_t)(u.sj * S) << 16);
        for (int idx = lo + (int)threadIdx.x; idx < hi; idx += 512) { f32x4 sum = (f32x4){0.f, 0.f, 0.f, 0.f};
            for (int c0 = 0; c0 < S; c0 += 12) {
                f32x4 pv[12];
#pragma unroll
                for (int k = 0; k < 12; ++k) pv[k] = (c0 + k < S) ? *(const f32x4*)(pb + ((size_t)(c0 + k) << 16) + 4 * idx) : (f32x4){0.f, 0.f, 0.f, 0.f};
#pragma unroll
                for (int k = 0; k < 12; ++k) sum += pv[k]; }
            int trow, tcol; part_rc(idx, trow, tcol); const int row = u.pm * BM + trow, col = u.pn * BM + tcol;
            *(f32x4*)(xmid + (size_t)row * DM + col) = sum + *(const f32x4*)(xrow_ptr(xp, xs, meta, row) + col); }
    }
};
struct EpiDown {
    static constexpr bool PERM = false, MIDK = false, PRELOAD = false;
    PTab a; int S;
    __device__ __forceinline__ float* dst_row(float* out, int row) const {
        if (row >= NPR) return out + O_YS + (size_t)(row - NPR) * DM;
        const int b = row / TP, t = row - b * TP; return t < NMETA ? nullptr : out + O_YP + ((size_t)b * SEQ + (t - NMETA)) * DM;
    }
    __device__ __forceinline__ void operator()(const f32x4 (&acc)[2][2][4][2], const Unit& u, int wr, int wc, int fr, int fq) const {
        unsigned char* ws_ = AWS; const float* xmid = (const float*)(ws_ + WS_XMID); float* out = AOUT; float* part = (float*)(ws_ + WS_H); unsigned* cnt = (unsigned*)(ws_ + WS_CTL + 16384 + 8192);
        const int tcol0 = wc * 32 + 4 * fq;
        const bool whole = u.nk == DFF / 64;
        if (whole) {
#pragma unroll
            for (int ai = 0; ai < 2; ++ai)
#pragma unroll
                for (int m = 0; m < 4; ++m) { const int trow = ai * HALF + wr * 64 + m * 16 + fr, row = u.pm * BM + trow;
                    float* dst = dst_row(out, row);
                    if (!dst) continue;
                    const float* src = xmid + (size_t)row * DM + u.pn * BM;
#pragma unroll
                    for (int bj = 0; bj < 2; ++bj)
#pragma unroll
                        for (int n = 0; n < 2; ++n) { const int tcol = tcol0 + bj * HALF + n * 16; const f32x4 xr = *(const f32x4*)(src + tcol); *(f32x4*)(dst + u.pn * BM + tcol) = xr + acc[ai][bj][m][n]; } }
        } else {
            float* pt = part + ((size_t)(u.sj * S + u.sc) << 16) + 4 * (fr + 16 * fq) + 256 * (wr * 4 + wc);
#pragma unroll
            for (int ai = 0; ai < 2; ++ai)
#pragma unroll
                for (int m = 0; m < 4; ++m)
#pragma unroll
                    for (int bj = 0; bj < 2; ++bj)
#pragma unroll
                        for (int n = 0; n < 2; ++n) { store_wt(pt, acc[ai][bj][m][n]); pt += 2048; asm volatile("" : "+v"(pt)); }
        }
        if (!whole) split_publish(cnt + 64 * u.sj);
    }
    __device__ __forceinline__ void finish(const Unit& u) const {
        unsigned char* ws_ = AWS; const float* xmid = (const float*)(ws_ + WS_XMID); float* out = AOUT; float* part = (float*)(ws_ + WS_H); unsigned* cnt = (unsigned*)(ws_ + WS_CTL + 16384 + 8192);
        split_wait(cnt + 64 * u.sj, (unsigned)S);
        const int lo = u.sc * 16384 / S, hi = (u.sc + 1) * 16384 / S; const float* pb = part + ((size_t)(u.sj * S) << 16);
        for (int idx = lo + (int)threadIdx.x; idx < hi; idx += 512) { f32x4 sum = (f32x4){0.f, 0.f, 0.f, 0.f};
            for (int c0 = 0; c0 < S; c0 += 12) {
                f32x4 pv[12];
#pragma unroll
                for (int k = 0; k < 12; ++k) pv[k] = (c0 + k < S) ? *(const f32x4*)(pb + ((size_t)(c0 + k) << 16) + 4 * idx) : (f32x4){0.f, 0.f, 0.f, 0.f};
#pragma unroll
                for (int k = 0; k < 12; ++k) sum += pv[k]; }
            int trow, tcol; part_rc(idx, trow, tcol); const int row = u.pm * BM + trow, col = u.pn * BM + tcol;
            float* dst = dst_row(out, row);
            if (dst) *(f32x4*)(dst + col) = sum + *(const f32x4*)(xmid + (size_t)row * DM + col); }
    }
};
#define DPP_ROR1 0x121
#define DPP_ROR2 0x122
#define DPP_SHR1 0x111
#define DPP_SHR2 0x112
__device__ __forceinline__ float dppf(float old, float src, const int ctrl_sel) {
    const int o = __builtin_bit_cast(int, old), s = __builtin_bit_cast(int, src); int r;
    if (ctrl_sel == 0) r = __builtin_amdgcn_update_dpp(o, s, DPP_ROR1, 0xf, 0xf, true);
    else if (ctrl_sel == 1) r = __builtin_amdgcn_update_dpp(o, s, DPP_ROR2, 0xf, 0xf, true);
    else if (ctrl_sel == 2) r = __builtin_amdgcn_update_dpp(o, s, DPP_SHR1, 0xf, 0xf, false);
    else r = __builtin_amdgcn_update_dpp(o, s, DPP_SHR2, 0xf, 0xf, false);
    return __builtin_bit_cast(float, r);
}
struct EpiUp {
    static constexpr bool PERM = true, MIDK = false, PRELOAD = true;
    PTab a; LAS unsigned char* ldsb;
    __device__ __forceinline__ void preload(const Unit& u, LAS unsigned char* lds, int tid) const {
        if (tid < 256) { const int p = tid >> 5, c = tid & 31; const float* src = (p & 3) < 3 ? AIN(28) + (size_t)(p & 3) * DFF2 : AIN(29); src += (p >> 2) * DFF + u.pn * 128 + 4 * c;
            __builtin_amdgcn_global_load_lds((const unsigned*)src, (LAS unsigned*)(lds + 131072 + (tid >> 6) * 1024), 16, 0, 0); }
    }
    __device__ __forceinline__ void operator()(const f32x4 (&acc)[2][2][4][2], const Unit& u, int wr, int wc, int fr, int fq) const {
        const float* stconv = AIN(6); bf16_t* ACT = (bf16_t*)(AWS + WS_ACT); float* out = AOUT;
        const LAS f32x4* tb = (const LAS f32x4*)(ldsb + 131072);
        const int colv0 = u.pn * 128 + wc * 32 + 8 * fq;
        int tt[2][4];
#pragma unroll
        for (int ai = 0; ai < 2; ++ai)
#pragma unroll
            for (int m = 0; m < 4; ++m) { const int row = u.pm * 248 + 62 * (2 * ai + wr) - 2 + 16 * m + fr;
                tt[ai][m] = ((m == 0 && fr < 2) || row >= MROWS) ? -1 : (row >= NPR ? (1 << 20) + (row - NPR) : row % TP); }
#pragma unroll
        for (int n = 0; n < 2; ++n) {
            const int cv = colv0 + 4 * n, cg_ = DFF + cv;
            const int ci = wc * 8 + 2 * fq + n;
            const f32x4 w0v = tb[ci], w1v = tb[32 + ci], w2v = tb[64 + ci], bv = tb[96 + ci];
            const f32x4 w0g = tb[128 + ci], w1g = tb[160 + ci], w2g = tb[192 + ci], bg = tb[224 + ci];
#pragma unroll
            for (int ai = 0; ai < 2; ++ai) {
                const int rbase = u.pm * 248 + 62 * (2 * ai + wr) - 2;
                f32x4 pvv = (f32x4){0.f, 0.f, 0.f, 0.f}, pvg = pvv;
#pragma unroll
                for (int m = 0; m < 4; ++m) {
                    const f32x4 cvv = acc[ai][0][m][n], cvg = acc[ai][1][m][n];
                    f32x4 p1v, p2v, p1g, p2g;
#pragma unroll
                    for (int e = 0; e < 4; ++e) {
                        p1v[e] = dppf(0.f, fr == 15 ? pvv[e] : cvv[e], 0); p2v[e] = dppf(0.f, fr >= 14 ? pvv[e] : cvv[e], 1);
                        p1g[e] = dppf(0.f, fr == 15 ? pvg[e] : cvg[e], 0); p2g[e] = dppf(0.f, fr >= 14 ? pvg[e] : cvg[e], 1);
                    }
                    pvv = cvv; pvg = cvg;
                    const int t = tt[ai][m];
                    if (t >= 0) {
                        const int row = rbase + 16 * m + fr;
                        if (t <= 1 || t >= TP - 2) {
                            if (t >= (1 << 20)) {
                                const int s = t - (1 << 20); const float* sc = stconv + (size_t)s * 2 * DFF2;
                                p2v = *(const f32x4*)(sc + cv); p1v = *(const f32x4*)(sc + DFF2 + cv); p2g = *(const f32x4*)(sc + cg_); p1g = *(const f32x4*)(sc + DFF2 + cg_);
                                float* so = out + O_SCONV + (size_t)s * 2 * DFF2;
                                *(f32x4*)(so + cv) = p1v; *(f32x4*)(so + cg_) = p1g; *(f32x4*)(so + DFF2 + cv) = cvv; *(f32x4*)(so + DFF2 + cg_) = cvg;
                            } else {
                                if (t == 0) { p1v = (f32x4){0.f, 0.f, 0.f, 0.f}; p1g = p1v; }
                                if (t <= 1) { p2v = (f32x4){0.f, 0.f, 0.f, 0.f}; p2g = p2v; }
                                if (t >= TP - 2) { const int b = row / TP; float* po = out + O_PCONV + ((size_t)b * 2 + (t - (TP - 2))) * DFF2; *(f32x4*)(po + cv) = cvv; *(f32x4*)(po + cg_) = cvg; }
                            }
                        }
                        const f32x4 cval = bv + w0v * p2v + w1v * p1v + w2v * cvv;
                        const f32x4 cgt = bg + w0g * p2g + w1g * p1g + w2g * cvg;
                        float o[4];
#pragma unroll
                        for (int e = 0; e < 4; ++e) o[e] = cgt[e] * sigmoidf_(cgt[e]) * cval[e];
                        u32x2 w; w.x = pk2(o[0], o[1]); w.y = pk2(o[2], o[3]);
                        *(u32x2*)(ACT + (size_t)row * DFF + cv) = w;
                    }
                }
            }
        }
    }
};
}

__device__ __forceinline__ void transpose_item(const float* W, int K, int N, bf16_t* WT, int mode, const float* ks0, const float* ks1, LAS float* scr, int item, int lane) {
    const int nblk = N / 32, kb = item / nblk, nb = item % nblk, k0 = 64 * kb, n0 = 32 * nb;
#pragma unroll 8
    for (int i = 0; i < 32; ++i) { const int kk = 2 * i + (lane >> 5); scr[kk * 33 + (lane & 31)] = W[(size_t)(k0 + kk) * N + n0 + (lane & 31)]; }
    asm volatile("s_waitcnt lgkmcnt(0)" ::: "memory");
    const int c = lane & 7;
    f32x4 ga = (f32x4){1.f, 1.f, 1.f, 1.f}, gb = ga;
    if (ks0) { const int k = k0 + 8 * c; const float* gp = k < 1024 ? ks0 + k : ks1 + (k - 1024); ga = *(const f32x4*)gp; gb = *(const f32x4*)(gp + 4); }
#pragma unroll
    for (int j = 0; j < 4; ++j) { const int n = (lane >> 3) + 8 * j; const LAS float* s = scr + (8 * c) * 33 + n;
        u32x4 o; o.x = pk2(s[0 * 33] * ga[0], s[1 * 33] * ga[1]); o.y = pk2(s[2 * 33] * ga[2], s[3 * 33] * ga[3]); o.z = pk2(s[4 * 33] * gb[0], s[5 * 33] * gb[1]); o.w = pk2(s[6 * 33] * gb[2], s[7 * 33] * gb[3]);
        const int col = n0 + n; int drow = col;
        if (mode == 1) { const int c2 = col < DFF ? col : col - DFF; drow = (c2 >> 7) * 256 + (col < DFF ? 0 : 128) + (c2 & 127); }
        *(u32x4*)(WT + (size_t)drow * K + k0 + 8 * c) = o; }
    asm volatile("s_waitcnt lgkmcnt(0)" ::: "memory");
}
__device__ __forceinline__ void rms_row_to_bf16(const float* xrow, const float* g, bf16_t* orow, int lane) {
    const f32x4* xr = (const f32x4*)xrow + lane; const f32x4* gr = (const f32x4*)g + lane;
    f32x4 v[8]; float s = 0.f;
#pragma unroll
    for (int j = 0; j < 8; ++j) { v[j] = xr[64 * j]; s += (v[j][0] * v[j][0] + v[j][1] * v[j][1]) + (v[j][2] * v[j][2] + v[j][3] * v[j][3]); }
    const float rstd = 1.0f / sqrtf(wave_sum(s) * (1.0f / DM) + EPS);
    u32x2* o8 = (u32x2*)orow + lane;
#pragma unroll
    for (int j = 0; j < 8; ++j) { const f32x4 gg = gr[64 * j]; u32x2 w; w.x = pk2(v[j][0] * rstd * gg[0], v[j][1] * rstd * gg[1]); w.y = pk2(v[j][2] * rstd * gg[2], v[j][3] * rstd * gg[3]); o8[64 * j] = w; }
}

__device__ __forceinline__ void s5_disc(const float* lam_re, const float* lam_im, int g, int p, float dt, float& are, float& aim, float& cre, float& cim) {
    const float lr = lam_re[g * 64 + p], li = lam_im[g * 64 + p];
    const float mag = expf(lr * dt);
    float sn, cs; sincos_rev((double)(li * dt) * 0.15915494309189533577, sn, cs);
    are = mag * cs; aim = mag * sn;
    const float den = lr * lr + li * li, am1 = are - 1.0f;
    cre = (am1 * lr + aim * li) / den; cim = (aim * lr - am1 * li) / den;
}

constexpr int SSM_WAVE_LDS = 12800 + 4096;
static_assert(8 * SSM_WAVE_LDS <= 146432, "SSM LDS vs the control words at the top of the allocation");
__device__ __forceinline__ void ssm_wave(const PTab a, LAS unsigned char* wl, bool sample, int bsel, int g, int lane) {
    const bf16_t* Z = (const bf16_t*)(AWS + WS_Z); bf16_t* YG = (bf16_t*)(AWS + WS_YG);
    const float *lam_re = AIN(13), *lam_im = AIN(14), *b_re = AIN(16), *b_im = AIN(17), *c_re = AIN(18), *c_im = AIN(19);
    LAS float* X = (LAS float*)wl; LAS bf16_t* Sb = (LAS bf16_t*)(wl + 8448);
    const int r16 = lane & 15, q4 = lane >> 4;
    const float dt = expf(AIN(15)[g]);
    float are, aim, tcr, tci; s5_disc(lam_re, lam_im, g, lane, dt, are, aim, tcr, tci);
    bf16x8 Bf[8];
#pragma unroll
    for (int blk = 0; blk < 8; ++blk) {
        const int p = 8 * blk + (r16 >> 1), c = r16 & 1;
        float d0, d1, cr, ci; s5_disc(lam_re, lam_im, g, p, dt, d0, d1, cr, ci);
        const float* br = b_re + ((size_t)g * 64 + p) * 16 + 8 * (q4 & 1); const float* bi = b_im + ((size_t)g * 64 + p) * 16 + 8 * (q4 & 1);
        bf16x8 f;
#pragma unroll
        for (int j = 0; j < 8; ++j) { const float v = c == 0 ? (cr * br[j] - ci * bi[j]) : (cr * bi[j] + ci * br[j]);
            const unsigned hi = f2bf(v); const float lo = v - __builtin_bit_cast(float, hi << 16);
            f[j] = (short)(q4 < 2 ? hi : f2bf(lo)); }
        Bf[blk] = f;
    }
    bf16x8 Cf[4];
#pragma unroll
    for (int kk = 0; kk < 4; ++kk) { bf16x8 f;
#pragma unroll
        for (int j = 0; j < 8; ++j) { const int p = 16 * kk + 4 * q4 + (j >> 1); const size_t ix = ((size_t)g * 16 + r16) * 64 + p;
            const float v = (j & 1) ? -c_im[ix] : c_re[ix]; f[j] = (short)f2bf(v); }
        Cf[kk] = f; }
    bf16x8 Df;
    { const float dsk = AIN(20)[g * 16 + r16]; const unsigned dhi = f2bf(dsk); const unsigned dlo = f2bf(dsk - __builtin_bit_cast(float, dhi << 16));
#pragma unroll
      for (int j = 0; j < 8; ++j) { const int kk = 8 * (q4 & 1) + j; Df[j] = (short)(kk == r16 ? (q4 < 2 ? dhi : dlo) : 0u); } }
    float sre = 0.f, sim = 0.f;
    const int nblk = sample ? 1 : TP / 16;
    const int rowbase = sample ? NPR + 16 * bsel : bsel * TP;
    const bf16_t* up = Z + (size_t)(rowbase + r16) * ZP + 16 * g + 8 * (q4 & 1);
    LAS bf16_t* Yb = (LAS bf16_t*)(wl + 12800);
    const int nch = (nblk + 7) / 8;
    bf16x8 Uc[8], Un[8];
#pragma unroll
    for (int i = 0; i < 8; ++i) { Uc[i] = (bf16x8){0, 0, 0, 0, 0, 0, 0, 0}; if (i < nblk) Uc[i] = *(const bf16x8*)(up + (size_t)(16 * i) * ZP); Un[i] = Uc[i]; }
    for (int ch = 0; ch < nch; ++ch) {
        const int nb = (nblk - 8 * ch) < 8 ? (nblk - 8 * ch) : 8;
        if (ch + 1 < nch) {
#pragma unroll
            for (int i = 0; i < 8; ++i) if (8 * (ch + 1) + i < nblk) Un[i] = *(const bf16x8*)(up + (size_t)(16 * (8 * (ch + 1) + i)) * ZP);
        }
#pragma unroll
        for (int i = 0; i < 8; ++i) {
            if (i < nb) {
                const bf16x8 Uf = Uc[i];
#pragma unroll
                for (int b8 = 0; b8 < 8; ++b8) {
                    f32x4 d = (f32x4){0.f, 0.f, 0.f, 0.f};
                    d = __builtin_amdgcn_mfma_f32_16x16x32_bf16(Bf[b8], Uf, d, 0, 0, 0);
                    *(LAS f32x4*)(X + r16 * 132 + 16 * b8 + 4 * q4) = d;
                }
                if (!sample) {
                    f32x2 xs[16];
#pragma unroll
                    for (int t = 0; t < 16; ++t) xs[t] = *(const LAS f32x2*)(X + t * 132 + 2 * lane);
#pragma unroll
                    for (int t = 0; t < 16; ++t) {
                        const float nr = are * sre - aim * sim + xs[t][0], ni = are * sim + aim * sre + xs[t][1];
                        sre = nr; sim = ni;
                        *(LAS unsigned*)(Sb + t * 136 + 2 * lane) = pk2(nr, ni);
                    }
                } else {
                    for (int t = 0; t < 16; ++t) {
                        const int s = 16 * bsel + t; const size_t ix = ((size_t)s * 64 + g) * 64 + lane;
                        const float h0r = AIN(4)[ix], h0i = AIN(5)[ix];
                        const f32x2 x = *(const LAS f32x2*)(X + t * 132 + 2 * lane);
                        const float nr = are * h0r - aim * h0i + x[0], ni = are * h0i + aim * h0r + x[1];
                        AOUT[O_SRE + ix] = nr; AOUT[O_SIM + ix] = ni;
                        *(LAS unsigned*)(Sb + t * 136 + 2 * lane) = pk2(nr, ni);
                    }
                }
                f32x4 y = (f32x4){0.f, 0.f, 0.f, 0.f};
                y = __builtin_amdgcn_mfma_f32_16x16x32_bf16(Uf, Df, y, 0, 0, 0);
#pragma unroll
                for (int kk = 0; kk < 4; ++kk) { const bf16x8 Af = *(const LAS bf16x8*)(Sb + r16 * 136 + 32 * kk + 8 * q4); y = __builtin_amdgcn_mfma_f32_16x16x32_bf16(Af, Cf[kk], y, 0, 0, 0); }
#pragma unroll
                for (int r = 0; r < 4; ++r) Yb[(16 * i + 4 * q4 + r) * 16 + r16] = (bf16_t)(pk2(gelu_tanh(y[r]), 0.f) & 0xffffu);
            }
        }
#pragma unroll
        for (int k = 0; k < 4; ++k) { const int rr = (lane >> 1) + 32 * k;
            if (rr < 16 * nb) *(u32x4*)(YG + (size_t)(rowbase + 128 * ch + rr) * DSSM + 16 * g + 8 * (lane & 1)) = *(const LAS u32x4*)(Yb + rr * 16 + 8 * (lane & 1)); }
#pragma unroll
        for (int i = 0; i < 8; ++i) Uc[i] = Un[i];
    }
    if (!sample) { const size_t ix = ((size_t)bsel * 64 + g) * 64 + lane; AOUT[O_PRE + ix] = sre; AOUT[O_PIM + ix] = sim; }
}


constexpr int PAIR_LDS = 8448 + 4 * 4352 + 4096 + 64;
constexpr int PAIR_RING = 8448, PAIR_YB = 8448 + 4 * 4352, PAIR_FLG = PAIR_YB + 4096;
static_assert(4 * PAIR_LDS <= 146432, "S5 pair regions vs the control words at the top of the allocation");
__device__ __forceinline__ void ssm_scan_role(const PTab a, LAS unsigned char* pl, int b, int g, int lane) {
    const bf16_t* Z = (const bf16_t*)(AWS + WS_Z);
    const float *lam_re = AIN(13), *lam_im = AIN(14), *b_re = AIN(16), *b_im = AIN(17);
    LAS float* X = (LAS float*)pl; volatile LAS unsigned* flg = (volatile LAS unsigned*)(pl + PAIR_FLG);
    const int r16 = lane & 15, q4 = lane >> 4;
    const float dt = expf(AIN(15)[g]);
    float are, aim, tcr, tci; s5_disc(lam_re, lam_im, g, lane, dt, are, aim, tcr, tci);
    bf16x8 Bf[8];
#pragma unroll
    for (int blk = 0; blk < 8; ++blk) {
        const int p = 8 * blk + (r16 >> 1), c = r16 & 1;
        float d0, d1, cr, ci; s5_disc(lam_re, lam_im, g, p, dt, d0, d1, cr, ci);
        const float* br = b_re + ((size_t)g * 64 + p) * 16 + 8 * (q4 & 1); const float* bi = b_im + ((size_t)g * 64 + p) * 16 + 8 * (q4 & 1);
        bf16x8 f;
#pragma unroll
        for (int j = 0; j < 8; ++j) { const float v = c == 0 ? (cr * br[j] - ci * bi[j]) : (cr * bi[j] + ci * br[j]);
            const unsigned hi = f2bf(v); const float lo = v - __builtin_bit_cast(float, hi << 16);
            f[j] = (short)(q4 < 2 ? hi : f2bf(lo)); }
        Bf[blk] = f;
    }
    float sre = 0.f, sim = 0.f;
    constexpr int nblk = TP / 16, nch = (nblk + 7) / 8;
    const int rowbase = b * TP;
    const bf16_t* up = Z + (size_t)(rowbase + r16) * ZP + 16 * g + 8 * (q4 & 1);
    bf16x8 Uc[8], Un[8];
#pragma unroll
    for (int i = 0; i < 8; ++i) { Uc[i] = *(const bf16x8*)(up + (size_t)(16 * i) * ZP); Un[i] = Uc[i]; }
    for (int ch = 0; ch < nch; ++ch) {
        const int nb = (nblk - 8 * ch) < 8 ? (nblk - 8 * ch) : 8;
        if (ch + 1 < nch) {
#pragma unroll
            for (int i = 0; i < 8; ++i) if (8 * (ch + 1) + i < nblk) Un[i] = *(const bf16x8*)(up + (size_t)(16 * (8 * (ch + 1) + i)) * ZP);
        }
#pragma unroll
        for (int i = 0; i < 8; ++i) {
            if (i < nb) {
                const int blk = 8 * ch + i;
#pragma unroll
                for (int b8 = 0; b8 < 8; ++b8) {
                    f32x4 d = (f32x4){0.f, 0.f, 0.f, 0.f};
                    d = __builtin_amdgcn_mfma_f32_16x16x32_bf16(Bf[b8], Uc[i], d, 0, 0, 0);
                    *(LAS f32x4*)(X + r16 * 132 + 16 * b8 + 4 * q4) = d;
                }
                f32x2 xs[16];
#pragma unroll
                for (int t = 0; t < 16; ++t) xs[t] = *(const LAS f32x2*)(X + t * 132 + 2 * lane);
                if (blk >= 4) { unsigned sp = 0; while (flg[1] < (unsigned)(blk - 3)) { __builtin_amdgcn_s_sleep(1); if (++sp > (1u << 22)) break; } }
                asm volatile("" ::: "memory");
                LAS bf16_t* Sw = (LAS bf16_t*)(pl + PAIR_RING + (i & 3) * 4352);
#pragma unroll
                for (int t = 0; t < 16; ++t) {
                    const float nr = are * sre - aim * sim + xs[t][0], ni = are * sim + aim * sre + xs[t][1];
                    sre = nr; sim = ni;
                    *(LAS unsigned*)(Sw + t * 136 + 2 * lane) = pk2(nr, ni);
                }
                asm volatile("s_waitcnt lgkmcnt(0)" ::: "memory");
                if (lane == 0) flg[0] = (unsigned)(blk + 1);
            }
        }
#pragma unroll
        for (int i = 0; i < 8; ++i) Uc[i] = Un[i];
    }
    { const size_t ix = ((size_t)b * 64 + g) * 64 + lane; AOUT[O_PRE + ix] = sre; AOUT[O_PIM + ix] = sim; }
}
__device__ __forceinline__ void ssm_out_role(const PTab a, LAS unsigned char* pl, int b, int g, int lane) {
    const bf16_t* Z = (const bf16_t*)(AWS + WS_Z); bf16_t* YG = (bf16_t*)(AWS + WS_YG);
    const float *c_re = AIN(18), *c_im = AIN(19);
    volatile LAS unsigned* flg = (volatile LAS unsigned*)(pl + PAIR_FLG); LAS bf16_t* Yb = (LAS bf16_t*)(pl + PAIR_YB);
    const int r16 = lane & 15, q4 = lane >> 4;
    bf16x8 Cf[4];
#pragma unroll
    for (int kk = 0; kk < 4; ++kk) { bf16x8 f;
#pragma unroll
        for (int j = 0; j < 8; ++j) { const int p = 16 * kk + 4 * q4 + (j >> 1); const size_t ix = ((size_t)g * 16 + r16) * 64 + p;
            const float v = (j & 1) ? -c_im[ix] : c_re[ix]; f[j] = (short)f2bf(v); }
        Cf[kk] = f; }
    bf16x8 Df;
    { const float dsk = AIN(20)[g * 16 + r16]; const unsigned dhi = f2bf(dsk); const unsigned dlo = f2bf(dsk - __builtin_bit_cast(float, dhi << 16));
#pragma unroll
      for (int j = 0; j < 8; ++j) { const int kk = 8 * (q4 & 1) + j; Df[j] = (short)(kk == r16 ? (q4 < 2 ? dhi : dlo) : 0u); } }
    constexpr int nblk = TP / 16, nch = (nblk + 7) / 8;
    const int rowbase = b * TP;
    const bf16_t* up = Z + (size_t)(rowbase + r16) * ZP + 16 * g + 8 * (q4 & 1);
    bf16x8 Uc[8], Un[8];
#pragma unroll
    for (int i = 0; i < 8; ++i) { Uc[i] = *(const bf16x8*)(up + (size_t)(16 * i) * ZP); Un[i] = Uc[i]; }
    for (int ch = 0; ch < nch; ++ch) {
        const int nb = (nblk - 8 * ch) < 8 ? (nblk - 8 * ch) : 8;
        if (ch + 1 < nch) {
#pragma unroll
            for (int i = 0; i < 8; ++i) if (8 * (ch + 1) + i < nblk) Un[i] = *(const bf16x8*)(up + (size_t)(16 * (8 * (ch + 1) + i)) * ZP);
        }
#pragma unroll
        for (int i = 0; i < 8; ++i) {
            if (i < nb) {
                const int blk = 8 * ch + i;
                { unsigned sp = 0; while (flg[0] < (unsigned)(blk + 1)) { __builtin_amdgcn_s_sleep(1); if (++sp > (1u << 22)) break; } }
                asm volatile("" ::: "memory");
                const LAS bf16_t* Sr = (const LAS bf16_t*)(pl + PAIR_RING + (i & 3) * 4352);
                bf16x8 Af[4];
#pragma unroll
                for (int kk = 0; kk < 4; ++kk) Af[kk] = *(const LAS bf16x8*)(Sr + r16 * 136 + 32 * kk + 8 * q4);
                asm volatile("s_waitcnt lgkmcnt(0)" ::: "memory");
                if (lane == 0) flg[1] = (unsigned)(blk + 1);
                f32x4 y = (f32x4){0.f, 0.f, 0.f, 0.f};
                y = __builtin_amdgcn_mfma_f32_16x16x32_bf16(Uc[i], Df, y, 0, 0, 0);
#pragma unroll
                for (int kk = 0; kk < 4; ++kk) y = __builtin_amdgcn_mfma_f32_16x16x32_bf16(Af[kk], Cf[kk], y, 0, 0, 0);
#pragma unroll
                for (int r = 0; r < 4; ++r) Yb[(16 * i + 4 * q4 + r) * 16 + r16] = (bf16_t)(pk2(gelu_tanh(y[r]), 0.f) & 0xffffu);
            }
        }
#pragma unroll
        for (int k = 0; k < 4; ++k) { const int rr = (lane >> 1) + 32 * k;
            if (rr < 16 * nb) *(u32x4*)(YG + (size_t)(rowbase + 128 * ch + rr) * DSSM + 16 * g + 8 * (lane & 1)) = *(const LAS u32x4*)(Yb + rr * 16 + 8 * (lane & 1)); }
#pragma unroll
        for (int i = 0; i < 8; ++i) Uc[i] = Un[i];
    }
}

__device__ __forceinline__ void attn_prompt_unit(const PTab a, LAS unsigned char* lds, int b, int kh, int qb, int tid) {
    const bf16_t* Z = (const bf16_t*)(AWS + WS_Z); bf16_t* MIX = (bf16_t*)(AWS + WS_MIX); float* ssqA = (float*)(AWS + WS_SSQA);
    const f32x2* rope = (const f32x2*)(AWS + WS_ROPE);
    const float *qg = AIN(10), *kg = AIN(11);
    LAS bf16_t* KT = (LAS bf16_t*)lds; LAS bf16_t* VT = (LAS bf16_t*)(lds + 27648);
    const int t0 = qb * 64, tk0 = t0 - 128;
    const int wave = tid >> 6, lane = tid & 63;
    const int head = kh * 4 + (wave & 3), half = wave >> 2, r32 = lane & 31, hf = lane >> 5;
    const int tq0 = t0 + 32 * half, tq = tq0 + r32; const bool qvalid = tq < TP;
    const int qrow = b * TP + (qvalid ? tq : TP - 1);
    u32x4 qraw[4];
    { const bf16_t* qp = Z + (size_t)qrow * ZP + 1024 + head * 64 + 8 * hf;
#pragma unroll
      for (int ks = 0; ks < 4; ++ks) qraw[ks] = *(const u32x4*)(qp + 16 * ks); }
    __syncthreads();
#pragma unroll 1
    for (int pass = 0; pass < 3; ++pass) {
        const int idx = pass * 512 + tid, key = idx >> 3, i = idx & 7, t = tk0 + key; const bool valid = t >= 0 && t < TP;
        u32x2 r1 = (u32x2){0u, 0u}, r2 = r1;
        if (valid) { const bf16_t* kp = Z + (size_t)(b * TP + t) * ZP + 2048 + kh * 64; r1 = *(const u32x2*)(kp + 4 * i); r2 = *(const u32x2*)(kp + 32 + 4 * i); }
        float x1[4] = {bflo(r1.x), bfhi(r1.x), bflo(r1.y), bfhi(r1.y)}, x2[4] = {bflo(r2.x), bfhi(r2.x), bflo(r2.y), bfhi(r2.y)};
        float ss = 0.f;
#pragma unroll
        for (int e = 0; e < 4; ++e) ss += x1[e] * x1[e] + x2[e] * x2[e];
        ss += __shfl_xor(ss, 1); ss += __shfl_xor(ss, 2); ss += __shfl_xor(ss, 4);
        const float rstd = 1.0f / sqrtf(ss * (1.0f / 64.0f) + EPS);
        float o1[4], o2[4];
        const f32x4* rp = (const f32x4*)(rope + (size_t)(valid ? t : 0) * 32 + 4 * i);
        const f32x4 ra = rp[0], rb = rp[1]; const float cs_c[4] = {ra[0], ra[2], rb[0], rb[2]}, cs_s[4] = {ra[1], ra[3], rb[1], rb[3]};
        const f32x4 g1 = *(const f32x4*)(kg + 4 * i), g2 = *(const f32x4*)(kg + 32 + 4 * i);
#pragma unroll
        for (int e = 0; e < 4; ++e) {
            const float y1 = x1[e] * rstd * g1[e], y2 = x2[e] * rstd * g2[e];
            o1[e] = y1 * cs_c[e] - y2 * cs_s[e]; o2[e] = y1 * cs_s[e] + y2 * cs_c[e]; }
        u32x2 w1, w2; w1.x = pk2(o1[0], o1[1]); w1.y = pk2(o1[2], o1[3]); w2.x = pk2(o2[0], o2[1]); w2.y = pk2(o2[2], o2[3]);
        *(LAS u32x2*)(KT + key * 72 + 4 * i) = w1; *(LAS u32x2*)(KT + key * 72 + 32 + 4 * i) = w2;
        if (valid && key >= 128 && t >= TP - 128) { float* po = AOUT + O_PK + (((size_t)b * 128 + (t - (TP - 128))) * 4 + kh) * 64;
            *(f32x4*)(po + 4 * i) = (f32x4){o1[0], o1[1], o1[2], o1[3]}; *(f32x4*)(po + 32 + 4 * i) = (f32x4){o2[0], o2[1], o2[2], o2[3]}; }
    }
#pragma unroll 1
    for (int pass = 0; pass < 3; ++pass) {
        const int idx = pass * 512 + tid, key = idx >> 3, j = idx & 7, t = tk0 + key; const bool valid = t >= 0 && t < TP;
        u32x4 r = (u32x4){0u, 0u, 0u, 0u};
        if (valid) r = *(const u32x4*)(Z + (size_t)(b * TP + t) * ZP + 2304 + kh * 64 + 8 * j);
        const unsigned w[4] = {r.x, r.y, r.z, r.w};
#pragma unroll
        for (int e = 0; e < 4; ++e) { VT[(8 * j + 2 * e) * 200 + key] = (bf16_t)(w[e] & 0xffffu); VT[(8 * j + 2 * e + 1) * 200 + key] = (bf16_t)(w[e] >> 16); }
        if (valid && key >= 128 && t >= TP - 128) { float* po = AOUT + O_PV + (((size_t)b * 128 + (t - (TP - 128))) * 4 + kh) * 64 + 8 * j;
            *(f32x4*)(po) = (f32x4){bflo(r.x), bfhi(r.x), bflo(r.y), bfhi(r.y)}; *(f32x4*)(po + 4) = (f32x4){bflo(r.z), bfhi(r.z), bflo(r.w), bfhi(r.w)}; }
    }
    __syncthreads();
    float qv[4][8];
    { float ss = 0.f;
#pragma unroll
      for (int ks = 0; ks < 4; ++ks) { const u32x4 r = qraw[ks];
          qv[ks][0] = bflo(r.x); qv[ks][1] = bfhi(r.x); qv[ks][2] = bflo(r.y); qv[ks][3] = bfhi(r.y); qv[ks][4] = bflo(r.z); qv[ks][5] = bfhi(r.z); qv[ks][6] = bflo(r.w); qv[ks][7] = bfhi(r.w);
#pragma unroll
          for (int j = 0; j < 8; ++j) ss += qv[ks][j] * qv[ks][j]; }
      ss += __shfl_xor(ss, 32);
      const float rstd = 0.125f / sqrtf(ss * (1.0f / 64.0f) + EPS);
#pragma unroll
      for (int ks = 0; ks < 2; ++ks) {
          const f32x4* rp = (const f32x4*)(rope + (size_t)(qvalid ? tq : TP - 1) * 32 + 16 * ks + 8 * hf);
          const f32x4* gp1 = (const f32x4*)(qg + 16 * ks + 8 * hf); const f32x4* gp2 = (const f32x4*)(qg + 32 + 16 * ks + 8 * hf);
#pragma unroll
          for (int jj = 0; jj < 4; ++jj) { const f32x4 cs2 = rp[jj]; const f32x4 ga = gp1[jj >> 1], gb = gp2[jj >> 1];
#pragma unroll
              for (int e = 0; e < 2; ++e) { const int j = 2 * jj + e; const float c = cs2[2 * e], sn = cs2[2 * e + 1];
                  const float y1 = qv[ks][j] * rstd * ga[(j & 3)], y2 = qv[ks + 2][j] * rstd * gb[(j & 3)];
                  qv[ks][j] = y1 * c - y2 * sn; qv[ks + 2][j] = y1 * sn + y2 * c; } } } }
    bf16x8 qf[4];
#pragma unroll
    for (int ks = 0; ks < 4; ++ks)
#pragma unroll
        for (int j = 0; j < 8; ++j) qf[ks][j] = (short)f2bf(qv[ks][j]);
    const int wk0 = 32 * half;
    const float sink = AIN(12)[head];
    float mx = sink;
#pragma unroll 1
    for (int kb = 0; kb < 5; ++kb) {
        f32x16 s;
#pragma unroll
        for (int r = 0; r < 16; ++r) s[r] = 0.f;
#pragma unroll
        for (int ks = 0; ks < 4; ++ks) { const bf16x8 kf = *(const LAS bf16x8*)(KT + (wk0 + 32 * kb + r32) * 72 + 16 * ks + 8 * hf);
            s = __builtin_amdgcn_mfma_f32_32x32x16_bf16(kf, qf[ks], s, 0, 0, 0); }
#pragma unroll
        for (int r = 0; r < 16; ++r) { const int i = (r & 3) + 8 * (r >> 2) + 4 * hf; const int diff = 128 + r32 - 32 * kb - i; const int kp = tq - diff;
            const bool ok = diff >= 0 && diff < 128 && kp >= 0; mx = fmaxf(mx, ok ? s[r] : -1e30f); }
    }
    mx = fmaxf(mx, __shfl_xor(mx, 32));
    float lsum = 0.f;
    f32x16 oacc[2];
#pragma unroll
    for (int db = 0; db < 2; ++db)
#pragma unroll
        for (int r = 0; r < 16; ++r) oacc[db][r] = 0.f;
#pragma unroll 1
    for (int kb = 0; kb < 5; ++kb) {
        f32x16 s;
#pragma unroll
        for (int r = 0; r < 16; ++r) s[r] = 0.f;
#pragma unroll
        for (int ks = 0; ks < 4; ++ks) { const bf16x8 kf = *(const LAS bf16x8*)(KT + (wk0 + 32 * kb + r32) * 72 + 16 * ks + 8 * hf);
            s = __builtin_amdgcn_mfma_f32_32x32x16_bf16(kf, qf[ks], s, 0, 0, 0); }
#pragma unroll
        for (int r = 0; r < 16; ++r) { const int i = (r & 3) + 8 * (r >> 2) + 4 * hf; const int diff = 128 + r32 - 32 * kb - i; const int kp = tq - diff;
            const bool ok = diff >= 0 && diff < 128 && kp >= 0; const float p = ok ? __expf(s[r] - mx) : 0.f; s[r] = p; lsum += p; }
#pragma unroll
        for (int s2 = 0; s2 < 2; ++s2) {
            bf16x8 pf;
#pragma unroll
            for (int j = 0; j < 8; ++j) pf[j] = (short)f2bf(s[8 * s2 + j]);
#pragma unroll
            for (int db = 0; db < 2; ++db) {
                const LAS bf16_t* vp = VT + (32 * db + r32) * 200 + wk0 + 32 * kb + 16 * s2 + 4 * hf;
                const u32x2 v0 = *(const LAS u32x2*)vp, v1 = *(const LAS u32x2*)(vp + 8);
                u32x4 vv; vv.x = v0.x; vv.y = v0.y; vv.z = v1.x; vv.w = v1.y;
                oacc[db] = __builtin_amdgcn_mfma_f32_32x32x16_bf16(__builtin_bit_cast(bf16x8, vv), pf, oacc[db], 0, 0, 0);
            }
        }
    }
    lsum += __shfl_xor(lsum, 32);
    lsum += __expf(sink - mx);
    const float inv = 1.0f / lsum; float ss = 0.f;
#pragma unroll
    for (int db = 0; db < 2; ++db)
#pragma unroll
        for (int r = 0; r < 16; ++r) { const float o = oacc[db][r] * inv; oacc[db][r] = o; ss += o * o; }
    ss += __shfl_xor(ss, 32);
    if (qvalid) {
        bf16_t* op = MIX + (size_t)qrow * DM + 1024 + head * 64;
#pragma unroll
        for (int db = 0; db < 2; ++db)
#pragma unroll
            for (int g4 = 0; g4 < 4; ++g4) { u32x2 w; w.x = pk2(oacc[db][4 * g4], oacc[db][4 * g4 + 1]); w.y = pk2(oacc[db][4 * g4 + 2], oacc[db][4 * g4 + 3]);
                *(u32x2*)(op + 32 * db + 8 * g4 + 4 * hf) = w; }
        if (hf == 0) unsafeAtomicAdd(ssqA + qrow, ss);
    }
}

__device__ __forceinline__ void attn_sample_unit(const PTab a, LAS unsigned char* lds, int s, int tid) {
    const bf16_t* Z = (const bf16_t*)(AWS + WS_Z); bf16_t* MIX = (bf16_t*)(AWS + WS_MIX); float* ssqA = (float*)(AWS + WS_SSQA);
    const f32x2* rope = (const f32x2*)(AWS + WS_ROPE) + (size_t)TP * 32;
    LAS float* qs = (LAS float*)lds;
    LAS float* kn = qs + 1024;
    LAS float* vn = kn + 256;
    LAS float* sc = vn + 256;
    LAS float* red = sc + 2048;
    const int wave = tid >> 6, lane = tid & 63, row = NPR + s;
    const bf16_t* zr = Z + (size_t)row * ZP;
    __syncthreads();
    const f32x2 cs = rope[lane & 31];
#pragma unroll 1
    for (int hh = 0; hh < 2; ++hh) { const int h = 2 * wave + hh; const float v = bf2f(zr[1024 + h * 64 + lane]);
        const float rstd = 1.0f / sqrtf(wave_sum(v * v) * (1.0f / 64.0f) + EPS); const float x = v * rstd * AIN(10)[lane]; const float pr = __shfl_xor(x, 32);
        const float o = lane < 32 ? x * cs[0] - pr * cs[1] : pr * cs[1] + x * cs[0]; qs[h * 64 + lane] = o * 0.125f; }
    if (wave < 4) { const int kh = wave; const float v = bf2f(zr[2048 + kh * 64 + lane]);
        const float rstd = 1.0f / sqrtf(wave_sum(v * v) * (1.0f / 64.0f) + EPS); const float x = v * rstd * AIN(11)[lane]; const float pr = __shfl_xor(x, 32);
        const float o = lane < 32 ? x * cs[0] - pr * cs[1] : pr * cs[1] + x * cs[0]; kn[kh * 64 + lane] = o;
        AOUT[O_SK + (((size_t)s * 128 + 127) * 4 + kh) * 64 + lane] = o;
        const float vv = bf2f(zr[2304 + kh * 64 + lane]); vn[kh * 64 + lane] = vv; AOUT[O_SV + (((size_t)s * 128 + 127) * 4 + kh) * 64 + lane] = vv; }
    __syncthreads();
    { const int j = tid & 127, kh = tid >> 7; float acc4[4] = {0.f, 0.f, 0.f, 0.f};
      const float* kp = AIN(2) + (((size_t)s * 128 + (j < 127 ? j + 1 : 127)) * 4 + kh) * 64;
#pragma unroll 4
      for (int d4 = 0; d4 < 16; ++d4) { f32x4 kv; if (j < 127) kv = *(const f32x4*)(kp + 4 * d4); else kv = *(const LAS f32x4*)(kn + kh * 64 + 4 * d4);
#pragma unroll
          for (int hq = 0; hq < 4; ++hq) { const f32x4 q = *(const LAS f32x4*)(qs + (kh * 4 + hq) * 64 + 4 * d4); acc4[hq] += (kv[0] * q[0] + kv[1] * q[1]) + (kv[2] * q[2] + kv[3] * q[3]); } }
#pragma unroll
      for (int hq = 0; hq < 4; ++hq) sc[(kh * 4 + hq) * 128 + j] = acc4[hq]; }
    __syncthreads();
#pragma unroll 1
    for (int hh = 0; hh < 2; ++hh) { const int h = 2 * wave + hh; const float v0 = sc[h * 128 + lane], v1 = sc[h * 128 + 64 + lane]; const float sink = AIN(12)[h];
        const float m = fmaxf(wave_max(fmaxf(v0, v1)), sink); const float p0 = __expf(v0 - m), p1 = __expf(v1 - m);
        const float inv = 1.0f / (wave_sum(p0 + p1) + __expf(sink - m)); sc[h * 128 + lane] = p0 * inv; sc[h * 128 + 64 + lane] = p1 * inv; }
    __syncthreads();
    { const int d4 = tid & 15, kh = (tid >> 4) & 3, jp = tid >> 6; f32x4 acc4[4];
#pragma unroll
      for (int hq = 0; hq < 4; ++hq) acc4[hq] = (f32x4){0.f, 0.f, 0.f, 0.f};
#pragma unroll 4
      for (int jj = 0; jj < 16; ++jj) { const int j = jp * 16 + jj; f32x4 vv;
          if (j < 127) vv = *(const f32x4*)(AIN(3) + (((size_t)s * 128 + j + 1) * 4 + kh) * 64 + 4 * d4); else vv = *(const LAS f32x4*)(vn + kh * 64 + 4 * d4);
#pragma unroll
          for (int hq = 0; hq < 4; ++hq) acc4[hq] += sc[(kh * 4 + hq) * 128 + j] * vv; }
#pragma unroll
      for (int hq = 0; hq < 4; ++hq) *(LAS f32x4*)(red + (jp * 16 + kh * 4 + hq) * 64 + 4 * d4) = acc4[hq]; }
    __syncthreads();
    { const int h = tid >> 5, d2 = tid & 31; float o0 = 0.f, o1 = 0.f;
#pragma unroll
      for (int jp = 0; jp < 8; ++jp) { o0 += red[(jp * 16 + h) * 64 + d2]; o1 += red[(jp * 16 + h) * 64 + 32 + d2]; }
      float ss = o0 * o0 + o1 * o1;
#pragma unroll
      for (int o = 1; o < 32; o <<= 1) ss += __shfl_xor(ss, o);
      MIX[(size_t)row * DM + 1024 + h * 64 + d2] = (bf16_t)f2bf(o0); MIX[(size_t)row * DM + 1024 + h * 64 + 32 + d2] = (bf16_t)f2bf(o1);
      if (d2 == 0) unsafeAtomicAdd(ssqA + row, ss); }
}


#define XB_TMO      128
#define XB_XCNT(j)  (256  + 64 * (j))
#define XB_XSUB(j)  (1280 + 64 * (j))
#define XB_XGEN(j)  (2304 + 64 * (j))
#define XB_TOP      3328
#define XB_TOPGEN   3392
#define XCD_BAR_WORDS 3456
#define XB_SPIN_CAP (1u << 22)
__device__ __forceinline__ unsigned xb_ld(unsigned* p)              { return __hip_atomic_load(p, __ATOMIC_RELAXED, __HIP_MEMORY_SCOPE_AGENT); }
__device__ __forceinline__ unsigned xb_add(unsigned* p, unsigned v) { return __hip_atomic_fetch_add(p, v, __ATOMIC_RELAXED, __HIP_MEMORY_SCOPE_AGENT); }
__device__ __forceinline__ unsigned xb_xcc_id() { return (unsigned)__builtin_amdgcn_s_getreg((3 << 11) | 20) & 0xFu; }
#define XB_SPIN(cond, bar) do { unsigned _sp = 0; while (cond) { __builtin_amdgcn_s_sleep(1); \
    if ((++_sp & 255u) == 0u) { if (xb_ld(&(bar)[XB_TMO])) break; if (_sp > XB_SPIN_CAP) { atomicAdd(&(bar)[XB_TMO], 1u); break; } } } } while (0)
struct XcdBarrier { unsigned* bar; unsigned x; volatile LAS unsigned* st; };
__device__ __forceinline__ XcdBarrier xcd_barrier_post(unsigned* bar, volatile LAS unsigned* st) {
    XcdBarrier b; b.bar = bar; b.x = xb_xcc_id(); b.st = st;
    if (threadIdx.x == 0) (void)xb_add(&bar[XB_XCNT(b.x)], 1u);
    return b;
}
__device__ __forceinline__ void xcd_barrier_complete(unsigned* bar, unsigned x, unsigned& nloc, unsigned& nx) {
    const unsigned G = gridDim.x * gridDim.y * gridDim.z;
    unsigned sum, cnt, mine, sp = 0u;
    for (;;) {
        sum = 0u; cnt = 0u; mine = 0u;
#pragma unroll
        for (unsigned j = 0; j < 16; ++j) { const unsigned c = xb_ld(&bar[XB_XCNT(j)]); sum += c; cnt += (c > 0u) ? 1u : 0u; mine = (j == x) ? c : mine; }
        if (sum == G) break;
        __builtin_amdgcn_s_sleep(1);
        if ((++sp & 255u) == 0u) { if (xb_ld(&bar[XB_TMO])) break; if (sp > XB_SPIN_CAP) { atomicAdd(&bar[XB_TMO], 1u); break; } }
    }
    nloc = mine > 0u ? mine : 1u; nx = cnt > 0u ? cnt : 1u;
}
__device__ __forceinline__ void xcd_barrier(const XcdBarrier& b) {
    asm volatile("s_waitcnt vmcnt(0)" ::: "memory");
    __syncthreads();
    if (threadIdx.x == 0) {
        unsigned* bar = b.bar;
        __builtin_amdgcn_s_waitcnt(0);
        unsigned nloc = b.st[0], nx = b.st[1];
        if (nloc == 0u) { xcd_barrier_complete(bar, b.x, nloc, nx); b.st[0] = nloc; b.st[1] = nx; }
        const unsigned old = xb_add(&bar[XB_XSUB(b.x)], 1u);
        const unsigned gen = old / nloc;
        if (old + 1u == (gen + 1u) * nloc) {
            __builtin_amdgcn_fence(__ATOMIC_RELEASE, "agent");
            asm volatile("s_waitcnt vmcnt(0)" ::: "memory");
            const unsigned og = xb_add(&bar[XB_TOP], 1u);
            const unsigned tg = og / nx;
            if (og + 1u == (tg + 1u) * nx) xb_add(&bar[XB_TOPGEN], 1u);
            else XB_SPIN(xb_ld(&bar[XB_TOPGEN]) == tg, bar);
            __builtin_amdgcn_fence(__ATOMIC_ACQUIRE, "agent");
            xb_add(&bar[XB_XGEN(b.x)], 1u);
            asm volatile("s_waitcnt vmcnt(0)" ::: "memory");
        } else {
            XB_SPIN(xb_ld(&bar[XB_XGEN(b.x)]) == gen, bar);
            __builtin_amdgcn_fence(__ATOMIC_ACQUIRE, "agent");
            asm volatile("s_waitcnt vmcnt(0)" ::: "memory");
        }
    }
    __syncthreads();
}

__global__ void __launch_bounds__(512, 2) hymba_fwd(Args ka) {
    extern __shared__ __attribute__((aligned(16))) unsigned char lds_raw[];
    LAS unsigned char* lds = (LAS unsigned char*)lds_raw;
    cg::grid_group grid = cg::this_grid();
    const int tid = threadIdx.x, lane = tid & 63, wave = __builtin_amdgcn_readfirstlane(tid >> 6);
    const int G = gridDim.x, bx = blockIdx.x;
    const int gw = bx * 8 + wave, NGW = G * 8;
    const PTab a = (PTab)(lds + 146432 + 128);
#pragma unroll
    for (int i = 0; i < 31; ++i) if (tid == i) a[i] = (unsigned long long)ka.in[i];
    if (tid == 31) a[31] = (unsigned long long)ka.out;
    if (tid == 32) a[32] = (unsigned long long)ka.ws;
    __syncthreads();
    unsigned char* ws = AWS;
    volatile LAS unsigned* bst = (volatile LAS unsigned*)(lds + 146432 + 64);
    if (tid < 2) bst[tid] = 0u;
    __syncthreads();
    XcdBarrier xbar; xbar.bar = (unsigned*)(ws + WS_CTL); xbar.x = xb_xcc_id(); xbar.st = bst;
    if (bx == 0) for (int e = tid; e < (int)(CTL_BYTES / 4); e += 512) ((unsigned*)(ws + WS_CTL))[e] = 0u;
#define GSYNC() xcd_barrier(xbar)
    bf16_t* WinT = (bf16_t*)(ws + WS_WIN); bf16_t* WgluT = (bf16_t*)(ws + WS_WGLU); bf16_t* WoutT = (bf16_t*)(ws + WS_WOUT); bf16_t* WupT = (bf16_t*)(ws + WS_WUP); bf16_t* WdownT = (bf16_t*)(ws + WS_WDOWN);
    bf16_t* H = (bf16_t*)(ws + WS_H) + 2 * DM;
    bf16_t* Z = (bf16_t*)(ws + WS_Z); bf16_t* YG = (bf16_t*)(ws + WS_YG); bf16_t* MIX = (bf16_t*)(ws + WS_MIX); bf16_t* ACT = (bf16_t*)(ws + WS_ACT);
    float* XMID = (float*)(ws + WS_XMID); float* ssqS = (float*)(ws + WS_SSQS); float* ssqA = (float*)(ws + WS_SSQA);

#ifndef ONLY
#define ONLY -1
#endif
#define PHON(k) (ONLY < 0 || ONLY == (k))
#ifndef PROBE_PHASE
#define PROBE_PHASE -1
#endif
#define REP(k) for (int rep_ = 0; rep_ < ((PROBE_PHASE == (k)) ? 2 : 1); ++rep_)
    REP(0) if (PHON(0)) {
        LAS float* scr = (LAS float*)(lds + wave * 16384);
        constexpr int I_IN = (DM / 64) * (DIN / 32), I_GLU = (DSSM / 64) * (DSSM / 32), I_OUT = (DM / 64) * (DM / 32), I_UP = (DM / 64) * (DFF2 / 32), I_DN = (DFF / 64) * (DM / 32);
        constexpr int NITEMS = I_IN + I_GLU + I_OUT;
        for (int it = gw; it < I_IN; it += NGW) transpose_item(AIN(9), DM, DIN, WinT, 0, nullptr, nullptr, scr, it, lane);
        for (int m = gw; m < MROWS; m += NGW) rms_row_to_bf16(pg8::xrow_ptr(AIN(0), AIN(1), AIN(7), m), AIN(8), H + (size_t)m * DM, lane);
        f32x2* rope = (f32x2*)(ws + WS_ROPE);
        for (int e = bx * 512 + tid; e < NROPE * 32; e += G * 512) {
            const int pi = e >> 5, i = e & 31; const int pos = pi < TP ? pi : PASTLEN;
            double inv = 1.0; for (int k = 0; k < i; ++k) inv *= 0.74989420933245582730;
            const float ang = (float)pos * (float)inv; float sn, cs; sincos_rev((double)ang * 0.15915494309189533577, sn, cs);
            rope[e] = (f32x2){cs, sn};
        }
        for (int e = bx * 512 + tid; e < MROWS; e += G * 512) { ssqS[e] = 0.f; ssqA[e] = 0.f; }
    }
    grid.sync();
    if (tid == 0) (void)xb_add(&xbar.bar[XB_XCNT(xbar.x)], 1u);
    if (PHON(1)) { typedef pg8::Order<MROWS / 256, DIN / 256, DM / 64, false> Ord; Ord S; S.init(G, bx); pg8::EpiZ E{a};
      pg8::gemm_phase<pg8::EpiZ, false, Ord>(lds, H, WinT, S, E);
      constexpr int NU = (MROWS / 256) * (DIN / 256); const int nrem = NU % G;
      if (nrem > 0 && bx >= nrem) { LAS float* scr = (LAS float*)(lds + wave * 16384); constexpr int I_UP = (DM / 64) * (DFF2 / 32);
          for (int it = (bx - nrem) * 8 + wave; it < I_UP; it += (G - nrem) * 8) transpose_item(AIN(27), DM, DFF2, WupT, 1, nullptr, nullptr, scr, it, lane); }
      else if (nrem == 0) { LAS float* scr = (LAS float*)(lds + wave * 16384); constexpr int I_UP = (DM / 64) * (DFF2 / 32);
          for (int it = gw; it < I_UP; it += NGW) transpose_item(AIN(27), DM, DFF2, WupT, 1, nullptr, nullptr, scr, it, lane); } }
    GSYNC();
    if (PHON(2)) {
        constexpr int NSSM = 128;
        if (bx < NSSM) {
            LAS unsigned char* pl = lds + (wave & 3) * PAIR_LDS;
            if (wave < 4 && lane < 2) ((volatile LAS unsigned*)(pl + PAIR_FLG))[lane] = 0u;
            __syncthreads();
#ifndef NO_SSM
            const int un = bx * 4 + (wave & 3);
            if (wave < 4) { ssm_wave(a, pl, true, un >> 6, un & 63, lane);
                            ssm_scan_role(a, pl, un >> 6, un & 63, lane); }
            else ssm_out_role(a, pl, un >> 6, un & 63, lane);
#endif
        } else {
            const int nA = NB * 4 * 33, nTot = nA + NS;
#pragma unroll 1
            for (int it = bx - NSSM; it < nTot; it += G - NSSM) {
                if (it < nA) {
#ifndef NO_AP
                    const int b = it / 132, r = it - b * 132; attn_prompt_unit(a, lds, b, r / 33, r % 33, tid);
#endif
                } else {
#ifndef NO_AS
                    attn_sample_unit(a, lds, it - nA, tid);
#endif
                }
            }
        }
            __syncthreads();
            { LAS float* scr = (LAS float*)(lds + wave * 16384);
              const int cw = bx * 8 + wave, NCW = G * 8;
              constexpr int I_GLU = (DSSM / 64) * (DSSM / 32), I_OUT = (DM / 64) * (DM / 32), I_DN = (DFF / 64) * (DM / 32);
              for (int it = cw; it < I_GLU + I_OUT + I_DN; it += NCW) {
                  if (it < I_GLU) transpose_item(AIN(21), DSSM, DSSM, WgluT, 0, nullptr, nullptr, scr, it, lane);
                  else if (it < I_GLU + I_OUT) transpose_item(AIN(25), DM, DM, WoutT, 0, AIN(23), AIN(24), scr, it - I_GLU, lane);
                  else transpose_item(AIN(30), DFF, DM, WdownT, 0, nullptr, nullptr, scr, it - I_GLU - I_OUT, lane); }
              for (int e = cw * 64 + lane; e < NS * 127 * 64; e += NCW * 64) { const int s = e / (127 * 64), rj = e - s * (127 * 64), j = rj >> 6, c4 = rj & 63;
                  const size_t so = ((size_t)s * 128 + j + 1) * 256 + 4 * c4, dd = ((size_t)s * 128 + j) * 256 + 4 * c4;
                  *(f32x4*)(AOUT + O_SK + dd) = *(const f32x4*)(AIN(2) + so); *(f32x4*)(AOUT + O_SV + dd) = *(const f32x4*)(AIN(3) + so); } }
    }
    GSYNC();
    if (PHON(3)) { typedef pg8::Order<MROWS / 256, DSSM / 256, DSSM / 64, true> Ord; Ord S; S.init(G, bx); pg8::EpiGlu E{a, S.nsplit()};
      pg8::gemm_phase<pg8::EpiGlu, false, Ord>(lds, YG, WgluT, S, E);
      { pg8::Unit pu; if (S.piece(pu)) E.finish(pu); } }
    GSYNC();
    if (PHON(4)) { typedef pg8::Order<MROWS / 256, DM / 256, DM / 64, true> Ord; Ord S; S.init(G, bx); pg8::EpiOut E{a, S.nsplit(), ws};
      pg8::gemm_phase<pg8::EpiOut, false, Ord>(lds, MIX, WoutT, S, E);
      { pg8::Unit pu; if (S.piece(pu)) E.finish(pu); } }
    GSYNC();
    if (PHON(5)) for (int m = gw; m < MROWS; m += NGW) rms_row_to_bf16(XMID + (size_t)m * DM, AIN(26), H + (size_t)m * DM, lane);
    GSYNC();
    if (PHON(6)) { typedef pg8::Order<68, DFF2 / 256, DM / 64, false> Ord; Ord S; S.init(G, bx); pg8::EpiUp E{a, lds};
      pg8::gemm_phase<pg8::EpiUp, true, Ord>(lds, H - 2 * DM, WupT, S, E); }
    GSYNC();
    if (PHON(7)) { typedef pg8::Order<MROWS / 256, DM / 256, DFF / 64, true> Ord; Ord S; S.init(G, bx); pg8::EpiDown E{a, S.nsplit()};
      pg8::gemm_phase<pg8::EpiDown, false, Ord>(lds, ACT, WdownT, S, E);
      { pg8::Unit pu; if (S.piece(pu)) E.finish(pu); } }
}

extern "C" void kernel_launch(void* const* d_in, const int* in_sizes, int n_in, void* d_out, int out_size, void* d_ws, size_t ws_size, hipStream_t stream) {
    static int grid = 0;
    if (grid == 0) {
        if (n_in != 31 || (size_t)out_size != O_END || ws_size < WS_END) { fprintf(stderr, "kernel_launch: unexpected shapes: n_in %d out %d (want %zu) ws %zu (want %zu)\n", n_in, out_size, (size_t)O_END, ws_size, (size_t)WS_END); grid = -1; return; }
        int dev = 0, cus = 0, per_cu = 0;
        (void)hipGetDevice(&dev); (void)hipDeviceGetAttribute(&cus, hipDeviceAttributeMultiprocessorCount, dev);
        if (hipFuncSetAttribute((const void*)hymba_fwd, hipFuncAttributeMaxDynamicSharedMemorySize, LDS_BYTES) != hipSuccess) { fprintf(stderr, "kernel_launch: hipFuncSetAttribute failed\n"); grid = -1; return; }
        (void)hipOccupancyMaxActiveBlocksPerMultiprocessor(&per_cu, (const void*)hymba_fwd, 512, LDS_BYTES);
        if (per_cu < 1) { fprintf(stderr, "kernel_launch: occupancy query says %d blocks per CU\n", per_cu); per_cu = 1; }
        (void)hipGetLastError();
        grid = cus;
    }
    if (grid < 0) return;
    Args a{};
    for (int i = 0; i < 31; ++i) a.in[i] = (const float*)d_in[i];
    a.out = (float*)d_out; a.ws = (unsigned char*)d_ws;
    void* args[] = {&a};
    hipError_t e = hipLaunchCooperativeKernel((const void*)hymba_fwd, dim3(grid), dim3(512), args, LDS_BYTES, stream);
    if (e != hipSuccess) fprintf(stderr, "kernel_launch: cooperative launch failed: %s (grid %d)\n", hipGetErrorString(e), grid);
}
```
